# Optimizing an MI355X kernel written in HIP

```python
import jax, jax.numpy as jnp
from jax import lax
import numpy as np

D_MODEL = 1024
BATCH = 4
SEQ = 8192
DEPTH = 2

N_HEADS = 8
N_KV_HEADS = 2
HEAD_DIM = 64
ATTN_WIDTH = N_HEADS * HEAD_DIM
KV_WIDTH = N_KV_HEADS * HEAD_DIM
WINDOW = 128
ROT_DIM = HEAD_DIM // 4
ROPE_THETA = 500000.0
HGRN_HEADS = 4
HGRN_HEAD_DIM = 128
HGRN_WIDTH = HGRN_HEADS * HGRN_HEAD_DIM
CHUNK = 64
NORM_EPS = 1e-6
MASK_VALUE = -1e30
SPLITS = (ATTN_WIDTH, KV_WIDTH, KV_WIDTH, ATTN_WIDTH,
          HGRN_WIDTH, HGRN_WIDTH, HGRN_WIDTH, HGRN_WIDTH,
          D_MODEL, D_MODEL)
IN_WIDTH = 2 * ATTN_WIDTH + 2 * KV_WIDTH + 4 * HGRN_WIDTH + 2 * D_MODEL

kernel_name = 'hybrid_swa_sink_hgrn2_gated_merge'


def rms_norm(x, w):
    xf = x.astype(jnp.float32)
    y = xf * lax.rsqrt(jnp.mean(xf * xf, axis=-1, keepdims=True) + NORM_EPS)
    return (y * w.astype(jnp.float32)).astype(x.dtype)


def partial_rope(x, positions):
    half = ROT_DIM // 2
    inv_freq = jnp.power(ROPE_THETA, -jnp.arange(half, dtype=jnp.float32) * (2.0 / ROT_DIM))
    ang = positions.astype(jnp.float32)[..., None] * inv_freq
    cos = jnp.cos(ang)[:, :, None, :]
    sin = jnp.sin(ang)[:, :, None, :]
    xr = x[..., :ROT_DIM].astype(jnp.float32)
    x1, x2 = xr[..., :half], xr[..., half:]
    rot = jnp.concatenate([x1 * cos - x2 * sin, x2 * cos + x1 * sin], axis=-1)
    return jnp.concatenate([rot.astype(x.dtype), x[..., ROT_DIM:]], axis=-1)


def sliding_window_attention(q, k, v, sinks):
    B, T = q.shape[0], q.shape[1]
    nb = T // WINDOW
    G = N_HEADS // N_KV_HEADS
    qb = q.astype(jnp.float32).reshape(B, nb, WINDOW, N_KV_HEADS, G, HEAD_DIM) * (HEAD_DIM ** -0.5)

    def band(a):
        a = a.astype(jnp.float32).reshape(B, nb, WINDOW, N_KV_HEADS, HEAD_DIM)
        prev = jnp.pad(a[:, :-1], ((0, 0), (1, 0), (0, 0), (0, 0), (0, 0)))
        return jnp.concatenate([prev, a], axis=2)

    kb, vb = band(k), band(v)
    blk = jnp.arange(nb)[:, None]
    qpos = blk * WINDOW + jnp.arange(WINDOW)[None, :]
    kpos = (blk - 1) * WINDOW + jnp.arange(2 * WINDOW)[None, :]
    delta = qpos[:, :, None] - kpos[:, None, :]
    mask = (delta >= 0) & (delta < WINDOW) & (kpos[:, None, :] >= 0)
    s = jnp.einsum('bnqhgd,bnkhd->bhgnqk', qb, kb)
    s = jnp.where(mask, s, MASK_VALUE)
    sink = sinks.astype(jnp.float32).reshape(N_KV_HEADS, G)[None, :, :, None, None, None]
    m = jnp.maximum(jnp.max(s, axis=-1, keepdims=True), sink)
    p = jnp.exp(s - m)
    p = p / (jnp.sum(p, axis=-1, keepdims=True) + jnp.exp(sink - m))
    o = jnp.einsum('bhgnqk,bnkhd->bnqhgd', p, vb)
    return o.reshape(B, T, ATTN_WIDTH)


def hgrn2_recurrence(q, k, v, logf):
    B, T, H, Dk = q.shape
    Dv = v.shape[-1]
    n = T // CHUNK

    def chunks(a):
        return a.reshape(B, n, CHUNK, H, a.shape[-1]).transpose(1, 0, 3, 2, 4)

    causal = jnp.tril(jnp.ones((CHUNK, CHUNK), dtype=bool))[:, :, None]

    def step(S, blk):
        qc, kc, vc, gc = blk
        G = jnp.cumsum(gc, axis=-2)
        diff = G[:, :, :, None, :] - G[:, :, None, :, :]
        decay = jnp.exp(jnp.where(causal, diff, MASK_VALUE))
        scores = jnp.einsum('bhtd,bhsd,bhtsd->bhts', qc, kc, decay)
        o = (jnp.einsum('bhts,bhsv->bhtv', scores, vc)
             + jnp.einsum('bhtd,bhdv->bhtv', qc * jnp.exp(G), S))
        G_end = G[:, :, -1:, :]
        S = (S * jnp.exp(G_end)[:, :, 0, :, None]
             + jnp.einsum('bhsd,bhsv->bhdv', kc * jnp.exp(G_end - G), vc))
        return S, o

    S0 = jnp.zeros((B, H, Dk, Dv), jnp.float32)
    _, o = lax.scan(step, S0, (chunks(q), chunks(k), chunks(v), chunks(logf)))
    return o.transpose(1, 0, 3, 2, 4).reshape(B, T, H, Dv)


def setup_inputs(seed: int = 0) -> dict:
    key = jax.random.key(seed)
    ks = jax.random.split(key, 12)
    f32 = jnp.float32
    x = jax.random.normal(ks[0], (BATCH, SEQ, D_MODEL), f32)
    offsets = jax.random.randint(ks[1], (BATCH, 1), 0, 1024, dtype=jnp.int32)
    positions = (jnp.arange(SEQ, dtype=jnp.int32)[None, :] + offsets).astype(jnp.int32)
    norm_w = 1.0 + 0.02 * jax.random.normal(ks[2], (DEPTH, D_MODEL), f32)
    w_in = jax.random.normal(ks[3], (DEPTH, D_MODEL, IN_WIDTH), f32) * D_MODEL ** -0.5
    attn_sinks = 0.5 * jax.random.normal(ks[4], (DEPTH, N_HEADS), f32)
    hgrn_norm_w = 1.0 + 0.02 * jax.random.normal(ks[5], (DEPTH, HGRN_HEAD_DIM), f32)
    w_up_attn = jax.random.normal(ks[6], (DEPTH, ATTN_WIDTH, D_MODEL), f32) * ATTN_WIDTH ** -0.5
    w_up_hgrn = jax.random.normal(ks[7], (DEPTH, HGRN_WIDTH, D_MODEL), f32) * HGRN_WIDTH ** -0.5
    w_out = jax.random.normal(ks[8], (DEPTH, D_MODEL, D_MODEL), f32) * D_MODEL ** -0.5
    lb_logits = 0.1 * jax.random.normal(ks[9], (DEPTH, HGRN_WIDTH), f32)
    final_norm_w = 1.0 + 0.02 * jax.random.normal(ks[10], (D_MODEL,), f32)
    return {'x': x, 'positions': positions, 'norm_w': norm_w, 'w_in': w_in,
            'attn_sinks': attn_sinks, 'hgrn_norm_w': hgrn_norm_w, 'w_up_attn': w_up_attn,
            'w_up_hgrn': w_up_hgrn, 'w_out': w_out, 'lb_logits': lb_logits,
            'final_norm_w': final_norm_w}


def reference(x, positions, norm_w, w_in, attn_sinks, hgrn_norm_w, w_up_attn, w_up_hgrn,
              w_out, lb_logits, final_norm_w):
    B, T, _ = x.shape
    split_points = [int(s) for s in np.cumsum(SPLITS)[:-1]]
    lb_soft = jax.nn.softmax(lb_logits.astype(jnp.float32), axis=0)
    lb_all = jnp.cumsum(lb_soft, axis=0) - lb_soft[0]

    for layer in range(DEPTH):
        h = rms_norm(x, norm_w[layer])
        proj = h @ w_in[layer]
        (q, k, v, z_attn, q_h, f_h, i_h, g_h, gate_attn, gate_hgrn) = jnp.split(proj, split_points, axis=-1)

        q = partial_rope(q.reshape(B, T, N_HEADS, HEAD_DIM), positions)
        k = partial_rope(k.reshape(B, T, N_KV_HEADS, HEAD_DIM), positions)
        v = v.reshape(B, T, N_KV_HEADS, HEAD_DIM)
        a = sliding_window_attention(q, k, v, attn_sinks[layer]).astype(x.dtype) * jax.nn.silu(z_attn)

        lb = lb_all[layer]
        fx = f_h.astype(jnp.float32)
        logf = jnp.log(lb + (1.0 - lb) * jax.nn.sigmoid(fx))
        kin = (1.0 - lb) * jax.nn.sigmoid(-fx)
        qin = jax.nn.silu(q_h.astype(jnp.float32))
        heads = lambda t: t.reshape(B, T, HGRN_HEADS, HGRN_HEAD_DIM)
        o = hgrn2_recurrence(heads(qin), heads(kin), heads(i_h.astype(jnp.float32)), heads(logf))
        o = o * lax.rsqrt(jnp.mean(o * o, axis=-1, keepdims=True) + NORM_EPS) * hgrn_norm_w[layer].astype(jnp.float32)
        b = o.reshape(B, T, HGRN_WIDTH).astype(x.dtype) * jax.nn.silu(g_h)

        merged = (jax.nn.sigmoid(gate_attn) * (a @ w_up_attn[layer])
                  + jax.nn.sigmoid(gate_hgrn) * (b @ w_up_hgrn[layer]))
        x = x + merged @ w_out[layer]

    return rms_norm(x, final_norm_w)
```

```cpp
#include <hip/hip_runtime.h>
#include <cstdio>
#include <cstdint>
#include <cmath>

constexpr int D = 1024, BATCH = 4, T = 8192, DEPTH = 2, M = BATCH * T;
constexpr int NH = 8, NKV = 2, HD = 64, AW = 512, KVW = 128, WIN = 128;
constexpr int HH = 4, HDK = 128, HW = 512, CHUNK = 64;
constexpr int NIN = 5376;
constexpr float EPS = 1e-6f;
constexpr int C_Q = 0, C_K = 512, C_V = 640, C_Z = 768, C_QH = 1280, C_FH = 1792, C_IH = 2304, C_GH = 2816, C_GA = 3328, C_GB = 4352;

constexpr size_t MiB = 1u << 20;
constexpr size_t WS_CTL = 0;
constexpr size_t WS_WIN = 2 * MiB, WS_WUA = 23 * MiB, WS_WUH = 25 * MiB, WS_WOUT = 27 * MiB;
constexpr size_t WS_COS = 31 * MiB, WS_SIN = 32 * MiB, WS_LB = 33 * MiB, WS_SSQ = 33 * MiB + 512 * 1024;
constexpr size_t WS_HS = 34 * MiB, WS_HD = 50 * MiB;
constexpr size_t WS_XB = 52 * MiB, WS_Q = 116 * MiB, WS_KV = 148 * MiB, WS_ZS = 164 * MiB, WS_QH = 196 * MiB, WS_LOGF = 228 * MiB;
constexpr size_t WS_IH = 292 * MiB, WS_GS = 324 * MiB, WS_GA = 356 * MiB, WS_GB = 420 * MiB, WS_END = 484 * MiB;

typedef unsigned short bf16;

__device__ __forceinline__ unsigned f2bf(float f) { unsigned u = __builtin_bit_cast(unsigned, f); return (u + 0x7fffu + ((u >> 16) & 1u)) >> 16; }
__device__ __forceinline__ float bf2f(unsigned short h) { return __builtin_bit_cast(float, (unsigned)h << 16); }
__device__ __forceinline__ float sigm(float x) { return 1.f / (1.f + __expf(-x)); }
__device__ __forceinline__ float silu(float x) { return x * sigm(x); }
__host__ __device__ __forceinline__ int src_col(int n) {
    if (n >= C_V) return n;
    const int p = n & 63;
    if (p >= 16) return n;
    return (n & ~63) + (p & 1) * 8 + (p >> 1);
}

struct Ptrs {
    const float *x; const int* pos; const float *norm_w, *w_in, *sinks, *hnw, *w_ua, *w_uh, *w_out, *lb_logits, *fnw;
    float* out; unsigned char* ws;
};

__global__ void k_prep_weights(Ptrs p) {
    const size_t NW_IN = (size_t)DEPTH * NIN * D, NW_U = (size_t)DEPTH * D * AW, NW_O = (size_t)DEPTH * D * D;
    const size_t total = NW_IN + 2 * NW_U + NW_O;
    bf16* win = (bf16*)(p.ws + WS_WIN); bf16* wua = (bf16*)(p.ws + WS_WUA); bf16* wuh = (bf16*)(p.ws + WS_WUH); bf16* wout = (bf16*)(p.ws + WS_WOUT);
    for (size_t i = (size_t)blockIdx.x * blockDim.x + threadIdx.x; i < total; i += (size_t)gridDim.x * blockDim.x) {
        size_t r = i;
        if (r < NW_IN) { const int l = r / ((size_t)NIN * D); const int n = (r / D) % NIN, k = r % D;
            win[r] = f2bf(p.norm_w[l * D + k] * p.w_in[((size_t)l * D + k) * NIN + src_col(n)]); continue; }
        r -= NW_IN;
        if (r < NW_U) { const int l = r / ((size_t)D * AW); const int n = (r / AW) % D, k = r % AW; wua[r] = f2bf(p.w_ua[((size_t)l * AW + k) * D + n]); continue; }
        r -= NW_U;
        if (r < NW_U) { const int l = r / ((size_t)D * AW); const int n = (r / AW) % D, k = r % AW; wuh[r] = f2bf(p.w_uh[((size_t)l * AW + k) * D + n]); continue; }
        r -= NW_U;
        { const int l = r / ((size_t)D * D); const int n = (r / D) % D, k = r % D; wout[r] = f2bf(p.w_out[((size_t)l * D + k) * D + n]); }
    }
}
__global__ void k_prep_x(const float* src, unsigned char* ws) {
    const int lane = threadIdx.x & 63, wv = (blockIdx.x * blockDim.x + threadIdx.x) >> 6, nw = (gridDim.x * blockDim.x) >> 6;
    bf16* xb = (bf16*)(ws + WS_XB); float* ssq = (float*)(ws + WS_SSQ);
    for (int m = wv; m < M; m += nw) {
        for (int j = 0; j < 4; ++j) {
            const float4 v = *(const float4*)(src + (size_t)m * D + j * 256 + lane * 4);
            float s = v.x * v.x + v.y * v.y + v.z * v.z + v.w * v.w;
            for (int o = 1; o < 64; o <<= 1) s += __shfl_xor(s, o);
            ushort4 o4; o4.x = f2bf(v.x); o4.y = f2bf(v.y); o4.z = f2bf(v.z); o4.w = f2bf(v.w);
            *(ushort4*)(xb + (size_t)m * D + j * 256 + lane * 4) = o4;
            if (lane == 0) ssq[m * 4 + j] = s;
        }
    }
}
__global__ void k_prep_tables(Ptrs p) {
    float* cs = (float*)(p.ws + WS_COS); float* sn = (float*)(p.ws + WS_SIN); float* lb = (float*)(p.ws + WS_LB);
    const int i = blockIdx.x * blockDim.x + threadIdx.x;
    if (i < M * 8) {
        const int m = i >> 3, f = i & 7;
        const double inv = pow(500000.0, -(double)f / 8.0);
        const double ang = (double)p.pos[m] * inv;
        const double rev = ang * 0.15915494309189535;
        const double fr = rev - rint(rev);
        const float a = (float)(fr * 6.283185307179586);
        cs[i] = cosf(a); sn[i] = sinf(a);
    }
    if (i < HW) {
        float mx = -1e30f; for (int l = 0; l < DEPTH; ++l) mx = fmaxf(mx, p.lb_logits[l * HW + i]);
        float den = 0.f; for (int l = 0; l < DEPTH; ++l) den += expf(p.lb_logits[l * HW + i] - mx);
        float acc = 0.f;
        for (int l = 0; l < DEPTH; ++l) { const float s = expf(p.lb_logits[l * HW + i] - mx) / den; if (l > 0) acc += s; lb[l * HW + i] = acc; }
    }
}

__device__ __forceinline__ void inproj_store_pair(unsigned char* ws, int l, int m, int n, float v0, float v1) {
    if (n < C_V) {
        const int pp = n & 63;
        if (pp < 16) { const int f = pp >> 1; const float c = ((const float*)(ws + WS_COS))[m * 8 + f], s = ((const float*)(ws + WS_SIN))[m * 8 + f];
            const float r0 = v0 * c - v1 * s, r1 = v1 * c + v0 * s; v0 = r0; v1 = r1; }
        if (n < C_K) { v0 *= 0.125f; v1 *= 0.125f; *(unsigned*)((bf16*)(ws + WS_Q) + (size_t)m * AW + n) = f2bf(v0) | (f2bf(v1) << 16); }
        else *(unsigned*)((bf16*)(ws + WS_KV) + (size_t)m * 256 + (n - C_K)) = f2bf(v0) | (f2bf(v1) << 16);
    } else if (n < C_Z) { *(unsigned*)((bf16*)(ws + WS_KV) + (size_t)m * 256 + (n - C_K)) = f2bf(v0) | (f2bf(v1) << 16);
    } else if (n < C_QH) { *(unsigned*)((bf16*)(ws + WS_ZS) + (size_t)m * AW + (n - C_Z)) = f2bf(silu(v0)) | (f2bf(silu(v1)) << 16);
    } else if (n < C_FH) { *(unsigned*)((bf16*)(ws + WS_QH) + (size_t)m * HW + (n - C_QH)) = f2bf(silu(v0)) | (f2bf(silu(v1)) << 16);
    } else if (n < C_IH) {
        const int c = n - C_FH; const float* lbp = (const float*)(ws + WS_LB) + l * HW + c;
        float o[2]; const float vv[2] = {v0, v1};
#pragma unroll
        for (int e = 0; e < 2; ++e) { const float lb = lbp[e], x = vv[e];
            o[e] = (x < 0.f) ? __logf(lb + (1.f - lb) * sigm(x)) : log1pf(-(1.f - lb) * sigm(-x)); }
        *(float2*)((float*)(ws + WS_LOGF) + (size_t)m * HW + c) = make_float2(o[0], o[1]);
    } else if (n < C_GH) { *(unsigned*)((bf16*)(ws + WS_IH) + (size_t)m * HW + (n - C_IH)) = f2bf(v0) | (f2bf(v1) << 16);
    } else if (n < C_GA) { *(unsigned*)((bf16*)(ws + WS_GS) + (size_t)m * HW + (n - C_GH)) = f2bf(silu(v0)) | (f2bf(silu(v1)) << 16);
    } else if (n < C_GB) { *(unsigned*)((bf16*)(ws + WS_GA) + (size_t)m * D + (n - C_GA)) = f2bf(sigm(v0)) | (f2bf(sigm(v1)) << 16);
    } else { *(unsigned*)((bf16*)(ws + WS_GB) + (size_t)m * D + (n - C_GB)) = f2bf(sigm(v0)) | (f2bf(sigm(v1)) << 16); }
}

template <int EPI>
__global__ void __launch_bounds__(256) k_gemm_simple(const bf16* A, const bf16* Bt, int K, int N, Ptrs p, int l, const float* xold) {
    __shared__ float As[16][65], Bs[16][65];
    const int tx = threadIdx.x & 15, ty = threadIdx.x >> 4;
    const int m0 = blockIdx.y * 64, n0 = blockIdx.x * 64;
    float acc[4][4] = {};
    for (int k0 = 0; k0 < K; k0 += 16) {
        { const int r = threadIdx.x >> 2, c = (threadIdx.x & 3) * 4;
            const ushort4 a = *(const ushort4*)(A + (size_t)(m0 + r) * K + k0 + c); const ushort4 b = *(const ushort4*)(Bt + (size_t)(n0 + r) * K + k0 + c);
            As[c][r] = bf2f(a.x); As[c + 1][r] = bf2f(a.y); As[c + 2][r] = bf2f(a.z); As[c + 3][r] = bf2f(a.w);
            Bs[c][r] = bf2f(b.x); Bs[c + 1][r] = bf2f(b.y); Bs[c + 2][r] = bf2f(b.z); Bs[c + 3][r] = bf2f(b.w); }
        __syncthreads();
#pragma unroll
        for (int k = 0; k < 16; ++k) {
            float a[4], b[4];
#pragma unroll
            for (int i = 0; i < 4; ++i) { a[i] = As[k][ty * 4 + i]; b[i] = Bs[k][tx * 4 + i]; }
#pragma unroll
            for (int i = 0; i < 4; ++i)
#pragma unroll
                for (int j = 0; j < 4; ++j) acc[i][j] += a[i] * b[j];
        }
        __syncthreads();
    }
#pragma unroll
    for (int i = 0; i < 4; ++i) {
        const int m = m0 + ty * 4 + i;
        if (EPI == 0) {
            const float* ssq = (const float*)(p.ws + WS_SSQ) + m * 4;
            const float rstd = rsqrtf((ssq[0] + ssq[1] + ssq[2] + ssq[3]) * (1.f / D) + EPS);
#pragma unroll
            for (int j = 0; j < 4; j += 2) inproj_store_pair(p.ws, l, m, n0 + tx * 4 + j, acc[i][j] * rstd, acc[i][j + 1] * rstd);
        } else if (EPI == 1) {
            bf16* g = (bf16*)(p.ws + WS_GA) + (size_t)m * D + n0 + tx * 4;
#pragma unroll
            for (int j = 0; j < 4; ++j) g[j] = f2bf(bf2f(g[j]) * acc[i][j]);
        } else if (EPI == 2) {
            bf16* g = (bf16*)(p.ws + WS_GA) + (size_t)m * D + n0 + tx * 4; const bf16* gb = (const bf16*)(p.ws + WS_GB) + (size_t)m * D + n0 + tx * 4;
#pragma unroll
            for (int j = 0; j < 4; ++j) g[j] = f2bf(bf2f(g[j]) + bf2f(gb[j]) * acc[i][j]);
        } else {
#pragma unroll
            for (int j = 0; j < 4; ++j) p.out[(size_t)m * D + n0 + tx * 4 + j] = xold[(size_t)m * D + n0 + tx * 4 + j] + acc[i][j];
        }
    }
}

__global__ void __launch_bounds__(256) k_attn_simple(Ptrs p, int l) {
    const int lane = threadIdx.x & 63, wv = (blockIdx.x * blockDim.x + threadIdx.x) >> 6;
    if (wv >= M * NH) return;
    const int m = wv >> 3, h = wv & 7, kvh = h >> 2, t = m % T;
    const bf16* Q = (const bf16*)(p.ws + WS_Q) + (size_t)m * AW + h * HD; const bf16* KV = (const bf16*)(p.ws + WS_KV);
    float q[64];
#pragma unroll
    for (int d = 0; d < 64; ++d) q[d] = bf2f(Q[d]);
    float s[2];
#pragma unroll
    for (int e = 0; e < 2; ++e) { const int j = lane + 64 * e; const int tk = t - 127 + j;
        if (tk < 0) { s[e] = -1e30f; continue; }
        const bf16* kr = KV + (size_t)(m - 127 + j) * 256 + kvh * HD; float a = 0.f;
#pragma unroll
        for (int d = 0; d < 64; ++d) a += q[d] * bf2f(kr[d]);
        s[e] = a; }
    const float sink = p.sinks[l * NH + h];
    float mx = fmaxf(fmaxf(s[0], s[1]), sink);
    for (int o = 1; o < 64; o <<= 1) mx = fmaxf(mx, __shfl_xor(mx, o));
    float pr[2] = {__expf(s[0] - mx), __expf(s[1] - mx)};
    float sum = pr[0] + pr[1];
    for (int o = 1; o < 64; o <<= 1) sum += __shfl_xor(sum, o);
    sum += __expf(sink - mx);
    float o_d = 0.f;
    for (int j = 0; j < 128; ++j) { const float pj = __shfl(j < 64 ? pr[0] : pr[1], j & 63); const int tk = t - 127 + j; if (tk < 0) continue;
        o_d += pj * bf2f(KV[(size_t)(m - 127 + j) * 256 + 128 + kvh * HD + lane]); }
    o_d /= sum;
    bf16* zs = (bf16*)(p.ws + WS_ZS) + (size_t)m * AW + h * HD + lane;
    *zs = f2bf(o_d * bf2f(*zs));
}

__global__ void __launch_bounds__(128) k_hgrn_simple(Ptrs p, int l) {
    __shared__ float sf[128], sk[128], sq[128], red[2];
    const int b = blockIdx.x / HH, h = blockIdx.x % HH, dv = threadIdx.x;
    float S[128];
#pragma unroll
    for (int i = 0; i < 128; ++i) S[i] = 0.f;
    const float nw = p.hnw[l * HDK + dv];
    for (int t = 0; t < T; ++t) {
        const size_t m = (size_t)b * T + t;
        const float lf = ((const float*)(p.ws + WS_LOGF))[m * HW + h * HDK + dv];
        sf[dv] = __expf(lf); sk[dv] = -expm1f(lf); sq[dv] = bf2f(((const bf16*)(p.ws + WS_QH))[m * HW + h * HDK + dv]);
        const float v = bf2f(((const bf16*)(p.ws + WS_IH))[m * HW + h * HDK + dv]);
        __syncthreads();
        float o = 0.f;
#pragma unroll
        for (int i = 0; i < 128; ++i) { S[i] = sf[i] * S[i] + sk[i] * v; o += sq[i] * S[i]; }
        float ss = o * o;
        for (int off = 1; off < 64; off <<= 1) ss += __shfl_xor(ss, off);
        if ((dv & 63) == 0) red[dv >> 6] = ss;
        __syncthreads();
        const float tot = red[0] + red[1];
        bf16* g = (bf16*)(p.ws + WS_GS) + m * HW + h * HDK + dv;
        *g = f2bf(o * rsqrtf(tot * (1.f / HDK) + EPS) * nw * bf2f(*g));
        __syncthreads();
    }
}

__global__ void k_final_norm(Ptrs p) {
    const int lane = threadIdx.x & 63, wv = (blockIdx.x * blockDim.x + threadIdx.x) >> 6, nw = (gridDim.x * blockDim.x) >> 6;
    for (int m = wv; m < M; m += nw) {
        float4 v[4]; float s = 0.f;
        for (int j = 0; j < 4; ++j) { v[j] = *(const float4*)(p.out + (size_t)m * D + j * 256 + lane * 4); s += v[j].x * v[j].x + v[j].y * v[j].y + v[j].z * v[j].z + v[j].w * v[j].w; }
        for (int o = 1; o < 64; o <<= 1) s += __shfl_xor(s, o);
        const float r = rsqrtf(s * (1.f / D) + EPS);
        for (int j = 0; j < 4; ++j) { const float4 w = *(const float4*)(p.fnw + j * 256 + lane * 4);
            *(float4*)(p.out + (size_t)m * D + j * 256 + lane * 4) = make_float4(v[j].x * r * w.x, v[j].y * r * w.y, v[j].z * r * w.z, v[j].w * r * w.w); }
    }
}

extern "C" void kernel_launch(void* const* d_in, const int* in_sizes, int n_in, void* d_out, int out_size, void* d_ws, size_t ws_size, hipStream_t stream) {
    if (n_in != 11 || in_sizes[0] != M * D || out_size != M * D || ws_size < WS_END) { fprintf(stderr, "kernel_launch: unexpected shapes / workspace (%d inputs, in0 %d, out %d, ws %zu)\n", n_in, n_in > 0 ? in_sizes[0] : -1, out_size, ws_size); return; }
    Ptrs p{};
    p.x = (const float*)d_in[0]; p.pos = (const int*)d_in[1]; p.norm_w = (const float*)d_in[2]; p.w_in = (const float*)d_in[3]; p.sinks = (const float*)d_in[4]; p.hnw = (const float*)d_in[5];
    p.w_ua = (const float*)d_in[6]; p.w_uh = (const float*)d_in[7]; p.w_out = (const float*)d_in[8]; p.lb_logits = (const float*)d_in[9]; p.fnw = (const float*)d_in[10];
    p.out = (float*)d_out; p.ws = (unsigned char*)d_ws;
    unsigned char* ws = p.ws;
    k_prep_weights<<<2048, 256, 0, stream>>>(p);
    k_prep_tables<<<(M * 8 + 255) / 256, 256, 0, stream>>>(p);
    for (int l = 0; l < DEPTH; ++l) {
        const float* xcur = l == 0 ? p.x : p.out;
        k_prep_x<<<1024, 256, 0, stream>>>(xcur, ws);
        k_gemm_simple<0><<<dim3(NIN / 64, M / 64), 256, 0, stream>>>((const bf16*)(ws + WS_XB), (const bf16*)(ws + WS_WIN) + (size_t)l * NIN * D, D, NIN, p, l, nullptr);
        k_attn_simple<<<M * NH / 4, 256, 0, stream>>>(p, l);
        k_hgrn_simple<<<BATCH * HH, 128, 0, stream>>>(p, l);
        k_gemm_simple<1><<<dim3(D / 64, M / 64), 256, 0, stream>>>((const bf16*)(ws + WS_ZS), (const bf16*)(ws + WS_WUA) + (size_t)l * D * AW, AW, D, p, l, nullptr);
        k_gemm_simple<2><<<dim3(D / 64, M / 64), 256, 0, stream>>>((const bf16*)(ws + WS_GS), (const bf16*)(ws + WS_WUH) + (size_t)l * D * AW, AW, D, p, l, nullptr);
        k_gemm_simple<3><<<dim3(D / 64, M / 64), 256, 0, stream>>>((const bf16*)(ws + WS_GA), (const bf16*)(ws + WS_WOUT) + (size_t)l * D * D, D, D, p, l, xcur);
    }
    k_final_norm<<<1024, 256, 0, stream>>>(p);
}
```

```cpp
#include <hip/hip_runtime.h>
#include <cstdio>
#include <cstdint>
#include <cmath>

constexpr int D = 1024, BATCH = 4, T = 8192, DEPTH = 2, M = BATCH * T;
constexpr int NH = 8, NKV = 2, HD = 64, AW = 512, KVW = 128, WIN = 128;
constexpr int HH = 4, HDK = 128, HW = 512, CHUNK = 64;
constexpr int NIN = 5376;
constexpr float EPS = 1e-6f;
constexpr int C_Q = 0, C_K = 512, C_V = 640, C_Z = 768, C_QH = 1280, C_FH = 1792, C_IH = 2304, C_GH = 2816, C_GA = 3328, C_GB = 4352;

constexpr size_t MiB = 1u << 20;
constexpr size_t WS_CTL = 0;
constexpr size_t WS_WIN = 2 * MiB, WS_WUA = 23 * MiB, WS_WUH = 25 * MiB, WS_WOUT = 27 * MiB;
constexpr size_t WS_COS = 31 * MiB, WS_SIN = 32 * MiB, WS_LB = 33 * MiB, WS_SSQ = 34 * MiB;
constexpr size_t WS_HD = 36 * MiB, WS_HS = 37 * MiB;
constexpr size_t WS_XB = 54 * MiB, WS_Q = 118 * MiB, WS_KV = 150 * MiB, WS_ZS = 166 * MiB, WS_QH = 198 * MiB, WS_LOGF = 230 * MiB;
constexpr size_t WS_IH = 294 * MiB, WS_GS = 326 * MiB, WS_GA = 358 * MiB, WS_GB = 422 * MiB, WS_HSS = 486 * MiB, WS_END = 502 * MiB;

typedef unsigned short bf16;

__device__ __forceinline__ unsigned f2bf(float f) { unsigned u = __builtin_bit_cast(unsigned, f); return (u + 0x7fffu + ((u >> 16) & 1u)) >> 16; }
__device__ __forceinline__ float bf2f(unsigned short h) { return __builtin_bit_cast(float, (unsigned)h << 16); }
__device__ __forceinline__ float sigm(float x) { return 1.f / (1.f + __expf(-x)); }
__device__ __forceinline__ float silu(float x) { return x * sigm(x); }
__host__ __device__ __forceinline__ int src_col(int n) {
    if (n >= C_GA) { const int t = (n - C_GA) >> 8, r = (n - C_GA) & 255; return r < 128 ? C_GA + 128 * t + r : C_GB + 128 * t + (r - 128); }
    if (n >= C_V) return n;
    const int p = n & 63;
    if (p >= 16) return n;
    return (n & ~63) + (p & 1) * 8 + (p >> 1);
}

struct Ptrs {
    const float *x; const int* pos; const float *norm_w, *w_in, *sinks, *hnw, *w_ua, *w_uh, *w_out, *lb_logits, *fnw;
    float* out; unsigned char* ws;
};

namespace pg8 {
#define PG8_LAS __attribute__((address_space(3)))
typedef unsigned short bf16_t;
typedef short bf16x8 __attribute__((ext_vector_type(8)));
typedef float f32x4 __attribute__((ext_vector_type(4)));
typedef unsigned u32x4 __attribute__((ext_vector_type(4)));
constexpr int BM = 256, BK = 64, HALF = 128, HTB = HALF * BK * 2  , STAGE_BYTES = 8 * HTB, NXCD = 8, WGM = 8;

__host__ __device__ __forceinline__ int lds_byte(int r, int c) { const int st = (r >> 4) * 2 + (c >> 5), rr = r & 15, cc = c & 31, ob = rr * 64 + cc * 2; return st * 1024 + (ob ^ (((ob >> 9) & 1) << 5)); }
__host__ __device__ __forceinline__ void stage_rc(int b, int& R, int& C) { const int st = b / 1024, sb = b % 1024, swz = sb ^ (((sb >> 9) & 1) << 5); R = (st >> 1) * 16 + swz / 64; C = (st & 1) * 32 + (swz % 64) / 2; }
__host__ __device__ __forceinline__ int perm32(int rho) { const int n = rho >> 4, i = rho & 15; return 8 * (i >> 2) + 4 * n + (i & 3); }

struct Unit { int pm, pn, seg; };
struct Gemm { const bf16_t* A; const bf16_t* Bt; int M, N, K; const bf16_t* A2; const bf16_t* Bt2; };

struct StaticOrder {
    int nM, nN, nwg, G, c;
    __host__ __device__ void init(int M, int N, int G_, int c_) { nM = M / BM; nN = N / BM; nwg = nM * nN; G = G_; c = c_; }
    __host__ __device__ bool next(int i, Unit& u) const {
        const long L = (long)i * G + c; if (L >= nwg) return false;
        int wgid = (int)L; { const int q = nwg / NXCD, r = nwg % NXCD, xcd = wgid % NXCD, off = wgid / NXCD; wgid = (xcd < r ? xcd * (q + 1) : r * (q + 1) + (xcd - r) * q) + off; }
        const int nig = WGM * nN, gid = wgid / nig, fm = gid * WGM, gsz = (nM - fm) < WGM ? (nM - fm) : WGM;
        u.pm = fm + ((wgid % nig) % gsz); u.pn = (wgid % nig) / gsz; u.seg = 0; return true;
    }
    __device__ __forceinline__ void a_ready(const Unit&) const {}
    __device__ __forceinline__ void done(const Unit&) const {}
};

struct StaticOrder2 {
    StaticOrder so;
    __host__ __device__ void init(int M, int N, int G_, int c_) { so.init(M, N, G_, c_); }
    __host__ __device__ bool next(int i, Unit& u) const { if (!so.next(i >> 1, u)) return false; u.seg = i & 1; return true; }
    __device__ __forceinline__ void a_ready(const Unit&) const {}
    __device__ __forceinline__ void done(const Unit&) const {}
};
__device__ __forceinline__ unsigned cvt_pk_bf16(float lo, float hi) { unsigned r; asm volatile("v_cvt_pk_bf16_f32 %0, %1, %2" : "=v"(r) : "v"(lo), "v"(hi)); return r; }
typedef float f32x2 __attribute__((ext_vector_type(2)));
#define PG8_GAS __attribute__((address_space(1)))
__device__ __forceinline__ float fexp(float x) { return __builtin_amdgcn_exp2f(x * 1.4426950408889634f); }
__device__ __forceinline__ float fsig(float x) { return __builtin_amdgcn_rcpf(1.f + fexp(-x)); }
__device__ __forceinline__ float flog(float x) { return __builtin_amdgcn_logf(x) * 0.6931471805599453f; }
__device__ __forceinline__ u32x4 pack8(const f32x4& a, const f32x4& b) { u32x4 w; w.x = cvt_pk_bf16(a[0], a[1]); w.y = cvt_pk_bf16(a[2], a[3]); w.z = cvt_pk_bf16(b[0], b[1]); w.w = cvt_pk_bf16(b[2], b[3]); return w; }
__device__ __forceinline__ void unpack8(const u32x4& w, f32x4& a, f32x4& b) {
    a[0] = __builtin_bit_cast(float, w.x << 16); a[1] = __builtin_bit_cast(float, w.x & 0xffff0000u); a[2] = __builtin_bit_cast(float, w.y << 16); a[3] = __builtin_bit_cast(float, w.y & 0xffff0000u);
    b[0] = __builtin_bit_cast(float, w.z << 16); b[1] = __builtin_bit_cast(float, w.z & 0xffff0000u); b[2] = __builtin_bit_cast(float, w.w << 16); b[3] = __builtin_bit_cast(float, w.w & 0xffff0000u); }
__device__ __forceinline__ float logf_gate(float x, float lb) {
    const float e = fexp(-__builtin_fabsf(x)), r = __builtin_amdgcn_rcpf(1.f + e), sneg = e * r;
    const float kin = (1.f - lb) * sneg;
    const float ser = -kin * (1.f + kin * (0.5f + kin * (0.33333334f + 0.25f * kin)));
    const float f = (x < 0.f) ? (lb + (1.f - lb) * sneg) : (1.f - kin);
    const float lg = flog(f);
    return (x >= 0.f && kin < 0.03f) ? ser : lg;
}
struct EpiInProj {
    static constexpr bool PERM = true, AFTER_DRAIN = false;
    PG8_GAS unsigned char* ws; int l; bool dry;
    __device__ __forceinline__ void init(f32x4 (&acc)[2][2][4][2], const Unit&, int, int, int, int) const {
#pragma unroll
        for (int a = 0; a < 2; ++a)
#pragma unroll
            for (int b = 0; b < 2; ++b)
#pragma unroll
                for (int m = 0; m < 4; ++m)
#pragma unroll
                    for (int n = 0; n < 2; ++n) acc[a][b][m][n] = (f32x4){0.f, 0.f, 0.f, 0.f}; }
    __device__ __forceinline__ void operator()(const f32x4 (&acc)[2][2][4][2], const Unit& u, int wr, int wc, int fr, int fq) const {
        if (dry) { asm volatile("" :: "v"(acc[0][0][0][0]), "v"(acc[0][1][1][1]), "v"(acc[1][0][2][0]), "v"(acc[1][1][3][1])); return; }
        const int row0 = u.pm * BM + wr * 64 + fr;
        float rstd[2][4];
        { f32x4 sq[2][4];
#pragma unroll
            for (int ai = 0; ai < 2; ++ai)
#pragma unroll
                for (int m = 0; m < 4; ++m) sq[ai][m] = *(const PG8_GAS f32x4*)((const PG8_GAS float*)(ws + WS_SSQ) + (size_t)(row0 + ai * HALF + m * 16) * 16 + 4 * fq);
#pragma unroll
            for (int ai = 0; ai < 2; ++ai)
#pragma unroll
                for (int m = 0; m < 4; ++m) { float t = (sq[ai][m][0] + sq[ai][m][1]) + (sq[ai][m][2] + sq[ai][m][3]); t += __shfl_xor(t, 16); t += __shfl_xor(t, 32);
                    rstd[ai][m] = __builtin_amdgcn_rsqf(t * (1.f / D) + EPS); } }
        if (u.pn * BM >= C_GA) {
            const int dcol = 128 * (u.pn - C_GA / BM) + wc * 32 + 8 * fq;
#pragma unroll
            for (int ai = 0; ai < 2; ++ai)
#pragma unroll
                for (int m = 0; m < 4; ++m) { const int row = row0 + ai * HALF + m * 16; f32x4 r0, r1, g0, g1;
#pragma unroll
                    for (int e = 0; e < 4; ++e) {
                        const float ea0 = fexp(-acc[ai][0][m][0][e] * rstd[ai][m]), eb0 = __builtin_fminf(fexp(-acc[ai][1][m][0][e] * rstd[ai][m]), 1e18f);
                        const float ea1 = fexp(-acc[ai][0][m][1][e] * rstd[ai][m]), eb1 = __builtin_fminf(fexp(-acc[ai][1][m][1][e] * rstd[ai][m]), 1e18f);
                        g0[e] = __builtin_amdgcn_rcpf(1.f + eb0); r0[e] = (1.f + eb0) * __builtin_amdgcn_rcpf(1.f + ea0);
                        g1[e] = __builtin_amdgcn_rcpf(1.f + eb1); r1[e] = (1.f + eb1) * __builtin_amdgcn_rcpf(1.f + ea1); }
                    *(PG8_GAS u32x4*)((PG8_GAS bf16_t*)(ws + WS_GA) + (size_t)row * D + dcol) = pack8(r0, r1);
                    *(PG8_GAS u32x4*)((PG8_GAS bf16_t*)(ws + WS_GB) + (size_t)row * D + dcol) = pack8(g0, g1); }
            return;
        }
#pragma unroll
        for (int bj = 0; bj < 2; ++bj) {
            const int cseg = u.pn * BM + bj * HALF;
            const int cl = wc * 32 + 8 * fq;
            int kind, ldc, dcol; size_t boff;
            float scale = 1.f;
            if (cseg < C_K)       { kind = 3; boff = WS_Q;    ldc = AW;  dcol = cseg + cl; scale = 0.125f; }
            else if (cseg < C_V)  { kind = 3; boff = WS_KV;   ldc = 256; dcol = cseg - C_K + cl; }
            else if (cseg < C_Z)  { kind = 0; boff = WS_KV;   ldc = 256; dcol = cseg - C_K + cl; }
            else if (cseg < C_QH) { kind = 1; boff = WS_ZS;   ldc = AW;  dcol = cseg - C_Z + cl; }
            else if (cseg < C_FH) { kind = 1; boff = WS_QH;   ldc = HW;  dcol = cseg - C_QH + cl; }
            else if (cseg < C_IH) { kind = 4; boff = WS_LOGF; ldc = HW;  dcol = cseg - C_FH + cl; }
            else if (cseg < C_GH) { kind = 0; boff = WS_IH;   ldc = HW;  dcol = cseg - C_IH + cl; }
            else                  { kind = 1; boff = WS_GS;   ldc = HW;  dcol = cseg - C_GH + cl; }
            if (kind == 4) {
                const f32x4 lb0 = *(const PG8_GAS f32x4*)((const PG8_GAS float*)(ws + WS_LB) + l * HW + dcol), lb1 = *(const PG8_GAS f32x4*)((const PG8_GAS float*)(ws + WS_LB) + l * HW + dcol + 4);
#pragma unroll
                for (int ai = 0; ai < 2; ++ai)
#pragma unroll
                    for (int m = 0; m < 4; ++m) { const int row = row0 + ai * HALF + m * 16; const f32x4 v0 = acc[ai][bj][m][0] * rstd[ai][m], v1 = acc[ai][bj][m][1] * rstd[ai][m]; f32x4 o0, o1;
#pragma unroll
                        for (int e = 0; e < 4; ++e) { o0[e] = logf_gate(v0[e], lb0[e]); o1[e] = logf_gate(v1[e], lb1[e]); }
                        typedef _Float16 f16x2 __attribute__((ext_vector_type(2)));
                        u32x4 hw; hw.x = __builtin_bit_cast(unsigned, (f16x2){(_Float16)o0[0], (_Float16)o0[1]}); hw.y = __builtin_bit_cast(unsigned, (f16x2){(_Float16)o0[2], (_Float16)o0[3]});
                        hw.z = __builtin_bit_cast(unsigned, (f16x2){(_Float16)o1[0], (_Float16)o1[1]}); hw.w = __builtin_bit_cast(unsigned, (f16x2){(_Float16)o1[2], (_Float16)o1[3]});
                        *(PG8_GAS u32x4*)((PG8_GAS bf16_t*)(ws + boff) + (size_t)row * ldc + dcol) = hw; }
            } else if (kind == 3) {
                const bool rot = ((wc & 1) == 0) && (fq < 2);
#pragma unroll
                for (int ai = 0; ai < 2; ++ai)
#pragma unroll
                    for (int mp = 0; mp < 2; ++mp) {
                        f32x4 cs[2], sn[2];
                        if (rot) {
#pragma unroll
                            for (int mm = 0; mm < 2; ++mm) { const int row = row0 + ai * HALF + (2 * mp + mm) * 16; cs[mm] = *(const PG8_GAS f32x4*)((const PG8_GAS float*)(ws + WS_COS) + (size_t)row * 8 + 4 * fq); sn[mm] = *(const PG8_GAS f32x4*)((const PG8_GAS float*)(ws + WS_SIN) + (size_t)row * 8 + 4 * fq); } }
                        asm volatile("" ::: "memory");
#pragma unroll
                        for (int mm = 0; mm < 2; ++mm) { const int m = 2 * mp + mm; const int row = row0 + ai * HALF + m * 16; f32x4 v0 = acc[ai][bj][m][0] * rstd[ai][m], v1 = acc[ai][bj][m][1] * rstd[ai][m];
                            if (rot) { const f32x4 c = cs[mm], s = sn[mm];
                                f32x4 r0, r1;
                                r0[0] = v0[0] * c[0] - v0[1] * s[0]; r0[1] = v0[1] * c[0] + v0[0] * s[0]; r0[2] = v0[2] * c[1] - v0[3] * s[1]; r0[3] = v0[3] * c[1] + v0[2] * s[1];
                                r1[0] = v1[0] * c[2] - v1[1] * s[2]; r1[1] = v1[1] * c[2] + v1[0] * s[2]; r1[2] = v1[2] * c[3] - v1[3] * s[3]; r1[3] = v1[3] * c[3] + v1[2] * s[3];
                                v0 = r0; v1 = r1; }
                            v0 = v0 * scale; v1 = v1 * scale;
                            *(PG8_GAS u32x4*)((PG8_GAS bf16_t*)(ws + boff) + (size_t)row * ldc + dcol) = pack8(v0, v1); }
                        asm volatile("" ::: "memory"); }
            } else {
#pragma unroll
                for (int ai = 0; ai < 2; ++ai)
#pragma unroll
                    for (int m = 0; m < 4; ++m) { const int row = row0 + ai * HALF + m * 16; f32x4 v0 = acc[ai][bj][m][0] * rstd[ai][m], v1 = acc[ai][bj][m][1] * rstd[ai][m];
                        if (kind != 0) {
#pragma unroll
                            for (int e = 0; e < 4; ++e) { v0[e] *= fsig(v0[e]); v1[e] *= fsig(v1[e]); } }
                        *(PG8_GAS u32x4*)((PG8_GAS bf16_t*)(ws + boff) + (size_t)row * ldc + dcol) = pack8(v0, v1); }
            }
        }
    }
};
struct EpiUp2 {
    static constexpr bool PERM = true, AFTER_DRAIN = false;
    PG8_GAS unsigned char* ws; bool dry;
    __device__ __forceinline__ void init(f32x4 (&acc)[2][2][4][2], const Unit& u, int, int, int, int) const {
        if (u.seg != 0) return;
#pragma unroll
        for (int a = 0; a < 2; ++a)
#pragma unroll
            for (int b = 0; b < 2; ++b)
#pragma unroll
                for (int m = 0; m < 4; ++m)
#pragma unroll
                    for (int n = 0; n < 2; ++n) acc[a][b][m][n] = (f32x4){0.f, 0.f, 0.f, 0.f}; }
    __device__ __forceinline__ void operator()(f32x4 (&acc)[2][2][4][2], const Unit& u, int wr, int wc, int fr, int fq) const {
        const int row0 = u.pm * BM + wr * 64 + fr, col0 = u.pn * BM + wc * 32 + 8 * fq;
        const size_t gbase = u.seg == 0 ? WS_GA : WS_GB;
#pragma unroll
        for (int am = 0; am < 4; ++am) { const int ai = am >> 1, mb = 2 * (am & 1);
            u32x4 gm[4][2];
#pragma unroll
            for (int m = mb; m < mb + 2; ++m)
#pragma unroll
                for (int bj = 0; bj < 2; ++bj) gm[m][bj] = *(const PG8_GAS u32x4*)((const PG8_GAS bf16_t*)(ws + gbase) + (size_t)(row0 + ai * HALF + m * 16) * D + col0 + bj * HALF);
            asm volatile("" ::: "memory");
#pragma unroll
            for (int m = mb; m < mb + 2; ++m)
#pragma unroll
                for (int bj = 0; bj < 2; ++bj) { f32x4 g0, g1; unpack8(gm[m][bj], g0, g1);
                    const f32x4 o0 = g0 * acc[ai][bj][m][0], o1 = g1 * acc[ai][bj][m][1];
                    if (u.seg == 0) { acc[ai][bj][m][0] = o0; acc[ai][bj][m][1] = o1; }
                    else if (!dry) *(PG8_GAS u32x4*)((PG8_GAS bf16_t*)(ws + WS_GA) + (size_t)(row0 + ai * HALF + m * 16) * D + col0 + bj * HALF) = pack8(o0, o1); }
            asm volatile("" ::: "memory");
        }
    }
};
struct EpiOut {
    static constexpr bool PERM = true, AFTER_DRAIN = false;
    PG8_GAS unsigned char* ws; const PG8_GAS float* xin; PG8_GAS float* out; const PG8_GAS float* fnw; PG8_LAS unsigned char* lx; bool last, dry;
    __device__ __forceinline__ void init(f32x4 (&acc)[2][2][4][2], const Unit& u, int wr, int wc, int fr, int fq) const {
        const int row0 = u.pm * BM + wr * 64 + fr, col0 = u.pn * BM + wc * 32 + 8 * fq;
        if (!last) {
#pragma unroll
            for (int ai = 0; ai < 2; ++ai)
#pragma unroll
                for (int bj = 0; bj < 2; ++bj)
#pragma unroll
                    for (int m = 0; m < 4; ++m) { const size_t off = (size_t)(row0 + ai * HALF + m * 16) * D + col0 + bj * HALF; acc[ai][bj][m][0] = *(const PG8_GAS f32x4*)(xin + off); acc[ai][bj][m][1] = *(const PG8_GAS f32x4*)(xin + off + 4); }
        } else {
#pragma unroll
            for (int ai = 0; ai < 2; ++ai)
#pragma unroll
                for (int bj = 0; bj < 2; ++bj)
#pragma unroll
                    for (int m = 0; m < 4; ++m) { const size_t off = (size_t)(row0 + ai * HALF + m * 16) * D + col0 + bj * HALF; const u32x4 wv = *(const PG8_GAS u32x4*)((const PG8_GAS bf16_t*)(ws + WS_XB) + off); unpack8(wv, acc[ai][bj][m][0], acc[ai][bj][m][1]); }
        }
    }
    __device__ __forceinline__ void operator()(const f32x4 (&acc)[2][2][4][2], const Unit& u, int wr, int wc, int fr, int fq) const {
        const int row0 = u.pm * BM + wr * 64 + fr, col0 = u.pn * BM + wc * 32 + 8 * fq;
        if (!last) {
#pragma unroll
            for (int ai = 0; ai < 2; ++ai)
#pragma unroll
                for (int m = 0; m < 4; ++m) { const int row = row0 + ai * HALF + m * 16; float ss = 0.f;
#pragma unroll
                    for (int bj = 0; bj < 2; ++bj) { const size_t off = (size_t)row * D + col0 + bj * HALF;
                        const f32x4 x0 = acc[ai][bj][m][0], x1 = acc[ai][bj][m][1];
                        if (!dry) *(PG8_GAS u32x4*)((PG8_GAS bf16_t*)(ws + WS_XB) + off) = pack8(x0, x1);
                        ss += ((x0[0] * x0[0] + x0[1] * x0[1]) + (x0[2] * x0[2] + x0[3] * x0[3])) + ((x1[0] * x1[0] + x1[1] * x1[1]) + (x1[2] * x1[2] + x1[3] * x1[3])); }
                    ss += __shfl_xor(ss, 16); ss += __shfl_xor(ss, 32);
                    if (fq == 0 && !dry) ((PG8_GAS float*)(ws + WS_SSQ))[(size_t)row * 16 + u.pn * 4 + wc] = ss; }
            return;
        }
        if (dry) { asm volatile("" :: "v"(acc[0][0][0][0]), "v"(acc[1][1][3][1])); return; }
        int tid = threadIdx.x; asm volatile("" : "+v"(tid));
        PG8_LAS float* P = (PG8_LAS float*)lx;
        PG8_LAS float* R = (PG8_LAS float*)(lx + 4096);
#pragma unroll
        for (int ai = 0; ai < 2; ++ai)
#pragma unroll
            for (int m = 0; m < 4; ++m) { float ss = 0.f;
#pragma unroll
                for (int bj = 0; bj < 2; ++bj) { const f32x4 x0 = acc[ai][bj][m][0], x1 = acc[ai][bj][m][1];
                    ss += ((x0[0] * x0[0] + x0[1] * x0[1]) + (x0[2] * x0[2] + x0[3] * x0[3])) + ((x1[0] * x1[0] + x1[1] * x1[1]) + (x1[2] * x1[2] + x1[3] * x1[3])); }
                ss += __shfl_xor(ss, 16); ss += __shfl_xor(ss, 32);
                if (fq == 0) P[(ai * HALF + wr * 64 + m * 16 + fr) * 4 + wc] = ss; }
        asm volatile("s_waitcnt lgkmcnt(0)" ::: "memory"); __builtin_amdgcn_s_barrier(); asm volatile("" ::: "memory");
        PG8_GAS unsigned* slots = (PG8_GAS unsigned*)(ws + WS_SSQ) + (size_t)u.pm * BM * 4;
        PG8_GAS unsigned* cnt = (PG8_GAS unsigned*)(ws + WS_CTL) + 32768 + 64 * u.pm;
        if (tid < BM) { const f32x4 pv = *(const PG8_LAS f32x4*)(P + tid * 4);
            __hip_atomic_store(slots + tid * 4 + u.pn, __builtin_bit_cast(unsigned, (pv[0] + pv[1]) + (pv[2] + pv[3])), __ATOMIC_RELAXED, __HIP_MEMORY_SCOPE_AGENT); }
        asm volatile("s_waitcnt vmcnt(0)" ::: "memory");
        __builtin_amdgcn_s_barrier(); asm volatile("" ::: "memory");
        if (tid == 0) __hip_atomic_fetch_add(cnt, 1u, __ATOMIC_RELAXED, __HIP_MEMORY_SCOPE_AGENT);
        if (tid < 64) { unsigned sp = 0;
            while ((unsigned)__builtin_amdgcn_readfirstlane(__hip_atomic_load(cnt, __ATOMIC_RELAXED, __HIP_MEMORY_SCOPE_AGENT)) < 4u) { __builtin_amdgcn_s_sleep(2); if (++sp > (1u << 16)) break; }
            __builtin_amdgcn_fence(__ATOMIC_ACQUIRE, "agent"); }
        asm volatile("s_waitcnt vmcnt(0) lgkmcnt(0)" ::: "memory"); __builtin_amdgcn_s_barrier(); asm volatile("" ::: "memory");
        if (tid < BM) { float tot = 0.f;
#pragma unroll
            for (int j = 0; j < 4; ++j) tot += __builtin_bit_cast(float, __hip_atomic_load(slots + tid * 4 + j, __ATOMIC_RELAXED, __HIP_MEMORY_SCOPE_AGENT));
            R[tid] = __builtin_amdgcn_rsqf(tot * (1.f / D) + EPS); }
        f32x4 gw[2][2];
#pragma unroll
        for (int bj = 0; bj < 2; ++bj) { gw[bj][0] = *(const PG8_GAS f32x4*)(fnw + col0 + bj * HALF); gw[bj][1] = *(const PG8_GAS f32x4*)(fnw + col0 + bj * HALF + 4); }
        asm volatile("s_waitcnt lgkmcnt(0)" ::: "memory"); __builtin_amdgcn_s_barrier(); asm volatile("" ::: "memory");
#pragma unroll
        for (int ai = 0; ai < 2; ++ai)
#pragma unroll
            for (int m = 0; m < 4; ++m) { const int rl = ai * HALF + wr * 64 + m * 16 + fr; const float rs = R[rl];
#pragma unroll
                for (int bj = 0; bj < 2; ++bj) { const size_t off = (size_t)(u.pm * BM + rl) * D + col0 + bj * HALF;
                    *(PG8_GAS f32x4*)(out + off) = acc[ai][bj][m][0] * rs * gw[bj][0]; *(PG8_GAS f32x4*)(out + off + 4) = acc[ai][bj][m][1] * rs * gw[bj][1]; } }
        asm volatile("s_waitcnt lgkmcnt(0)" ::: "memory"); __builtin_amdgcn_s_barrier(); asm volatile("" ::: "memory");
    }
};

template <class Epi, class Sched, bool ALIGN_EPI = false, bool SP2 = false>
__device__ __forceinline__ void gemm_phase(PG8_LAS unsigned char* lds, const Gemm g, const Sched& S, const Epi& E) {
    int tid_ = threadIdx.x; asm volatile("" : "+v"(tid_));
    const int tid = tid_, wid = __builtin_amdgcn_readfirstlane(tid >> 6), lane = tid & 63, wr = wid >> 2, wc = wid & 3, fr = lane & 15, fq = lane >> 4;
    const int K = g.K, nt = K / BK;
    unsigned voffA[2], voffB[2];
#pragma unroll
    for (int i = 0; i < 2; ++i) { int R, C; stage_rc(tid * 16 + i * 8192, R, C); const int Rb = Epi::PERM ? ((R & ~31) + perm32(R & 31)) : R;
        voffA[i] = (unsigned)(R * K + C) * 2u; voffB[i] = (unsigned)(Rb * K + C) * 2u; }
    const size_t kstep = (size_t)(BK * 2);
    const size_t hstep = (size_t)HALF * K * 2;
    const size_t tstep = 2 * hstep;
    const unsigned ldsw = (unsigned)wid * 1024u;
    const int aoff = lds_byte(wr * 64 + fr, fq * 8), boff = lds_byte(wc * 32 + fr, fq * 8);
#define PG8_SA(b, h) (((b) * 2 + (h)) * HTB)
#define PG8_SB(b, h) ((4 + (b) * 2 + (h)) * HTB)
#define PG8_STAGE(bufoff, gbase, voff) do { _Pragma("unroll") for (int _i = 0; _i < 2; ++_i) \
        __builtin_amdgcn_global_load_lds((const unsigned*)((const char*)(gbase) + (voff)[_i]), (PG8_LAS unsigned*)(lds + (bufoff) + ldsw + _i * 8192), 16, 0, 0); } while (0)
#define PG8_LDA(dst, b, h) do { _Pragma("unroll") for (int m = 0; m < 4; ++m) _Pragma("unroll") for (int k = 0; k < 2; ++k) dst[m][k] = *(const PG8_LAS bf16x8*)(lds + PG8_SA(b, h) + aoff + m * 2048 + k * 1024); } while (0)
#define PG8_LDB(dst, b, h) do { _Pragma("unroll") for (int n = 0; n < 2; ++n) _Pragma("unroll") for (int k = 0; k < 2; ++k) dst[n][k] = *(const PG8_LAS bf16x8*)(lds + PG8_SB(b, h) + boff + n * 2048 + k * 1024); } while (0)
#define PG8_MMA(ai, bj, At, Bt) do { __builtin_amdgcn_s_setprio(1); _Pragma("unroll") for (int m = 0; m < 4; ++m) _Pragma("unroll") for (int n = 0; n < 2; ++n) _Pragma("unroll") for (int k = 0; k < 2; ++k) \
        acc[ai][bj][m][n] = __builtin_amdgcn_mfma_f32_16x16x32_bf16(Bt[n][k], At[m][k], acc[ai][bj][m][n], 0, 0, 0); __builtin_amdgcn_s_setprio(0); } while (0)
#define PG8_WAIT_V(n) asm volatile("s_waitcnt vmcnt(" #n ")" ::: "memory")
#define PG8_WAIT_L(n) asm volatile("s_waitcnt lgkmcnt(" #n ")" ::: "memory")
#define PG8_BAR __builtin_amdgcn_s_barrier()
#define PG8_SCHED __builtin_amdgcn_sched_barrier(0)
    Unit cur, nxt; int ui = 0;
    if (!S.next(0, cur)) return;
    f32x4 acc[2][2][4][2];
    E.init(acc, cur, wr, wc, fr, fq);
    bf16x8 At[4][2], B0[2][2], B1[2][2];
    const char* cA = (const char*)(cur.seg ? g.A2 : g.A) + (size_t)cur.pm * tstep; const char* cB = (const char*)(cur.seg ? g.Bt2 : g.Bt) + (size_t)cur.pn * tstep;
    S.a_ready(cur);
    if constexpr (SP2) {
        PG8_STAGE(PG8_SB(0, 0), cB, voffB); PG8_STAGE(PG8_SB(0, 1), cB + hstep, voffB); PG8_STAGE(PG8_SA(0, 0), cA, voffA); PG8_STAGE(PG8_SA(0, 1), cA + hstep, voffA);
        if (wr == 1) PG8_BAR;
        PG8_WAIT_V(2); PG8_BAR;
        PG8_STAGE(PG8_SB(1, 0), cB + kstep, voffB); PG8_STAGE(PG8_SA(1, 0), cA + kstep, voffA); PG8_STAGE(PG8_SB(1, 1), cB + hstep + kstep, voffB);
        PG8_WAIT_V(6); PG8_BAR;
    } else {
        PG8_STAGE(PG8_SB(0, 0), cB, voffB); PG8_STAGE(PG8_SA(0, 0), cA, voffA); PG8_STAGE(PG8_SB(0, 1), cB + hstep, voffB); PG8_STAGE(PG8_SA(0, 1), cA + hstep, voffA);
        if (wr == 1) PG8_BAR;
        PG8_WAIT_V(4); PG8_BAR;
        PG8_STAGE(PG8_SB(1, 0), cB + kstep, voffB); PG8_STAGE(PG8_SA(1, 0), cA + kstep, voffA); PG8_STAGE(PG8_SB(1, 1), cB + hstep + kstep, voffB);
        PG8_WAIT_V(6); PG8_BAR;
    }
    for (;;) {
        const bool has_next = S.next(ui + 1, nxt);
        const char* nA = has_next ? (const char*)(nxt.seg ? g.A2 : g.A) + (size_t)nxt.pm * tstep : cA; const char* nB = has_next ? (const char*)(nxt.seg ? g.Bt2 : g.Bt) + (size_t)nxt.pn * tstep : cB;
        for (int t = 0; t < nt; t += 2) {
            const bool last = (t == nt - 2);
            const char* a1 = cA + (size_t)(t + 1) * kstep;
            const char* a2 = last ? nA : cA + (size_t)(t + 2) * kstep; const char* b2 = last ? nB : cB + (size_t)(t + 2) * kstep;
            const char* a3 = a2 + kstep; const char* b3 = b2 + kstep;
            if (last && has_next) S.a_ready(nxt);
            if constexpr (SP2) {
            PG8_LDB(B0, 0, 0); PG8_LDB(B1, 0, 1); PG8_SCHED; PG8_LDA(At, 0, 0); PG8_STAGE(PG8_SA(1, 1), a1 + hstep, voffA);
            PG8_WAIT_V(8); PG8_WAIT_L(0); PG8_BAR; PG8_MMA(0, 0, At, B0); PG8_MMA(0, 1, At, B1); PG8_BAR; PG8_SCHED;
            PG8_LDA(At, 0, 1); PG8_STAGE(PG8_SB(0, 0), b2, voffB); PG8_STAGE(PG8_SB(0, 1), b2 + hstep, voffB); PG8_STAGE(PG8_SA(0, 0), a2, voffA);
            PG8_WAIT_V(8); PG8_WAIT_L(0); PG8_BAR; PG8_MMA(1, 0, At, B0); PG8_MMA(1, 1, At, B1); PG8_BAR; PG8_SCHED;
            PG8_LDB(B0, 1, 0); PG8_LDB(B1, 1, 1); PG8_SCHED; PG8_LDA(At, 1, 0); PG8_STAGE(PG8_SA(0, 1), a2 + hstep, voffA);
            PG8_WAIT_V(8); PG8_WAIT_L(0); PG8_BAR; PG8_MMA(0, 0, At, B0); PG8_MMA(0, 1, At, B1); PG8_BAR; PG8_SCHED;
            PG8_LDA(At, 1, 1); PG8_STAGE(PG8_SB(1, 0), b3, voffB); PG8_STAGE(PG8_SB(1, 1), b3 + hstep, voffB); PG8_STAGE(PG8_SA(1, 0), a3, voffA);
            PG8_WAIT_V(8); PG8_WAIT_L(0); PG8_BAR; PG8_MMA(1, 0, At, B0); PG8_MMA(1, 1, At, B1); PG8_BAR; PG8_SCHED;
            } else {
            PG8_LDB(B0, 0, 0); PG8_SCHED; PG8_LDA(At, 0, 0); PG8_STAGE(PG8_SA(1, 1), a1 + hstep, voffA);
            PG8_WAIT_L(8); PG8_BAR; PG8_WAIT_L(0); PG8_MMA(0, 0, At, B0); PG8_BAR; PG8_SCHED;
            PG8_LDB(B1, 0, 1); PG8_STAGE(PG8_SB(0, 0), b2, voffB);
            PG8_BAR; PG8_WAIT_L(0); PG8_MMA(0, 1, At, B1); PG8_BAR;
            PG8_LDA(At, 0, 1); PG8_STAGE(PG8_SA(0, 0), a2, voffA);
            PG8_BAR; PG8_WAIT_L(0); PG8_MMA(1, 0, At, B0); PG8_BAR; PG8_SCHED;
            PG8_STAGE(PG8_SB(0, 1), b2 + hstep, voffB);
            PG8_WAIT_V(6); PG8_BAR; PG8_MMA(1, 1, At, B1); PG8_BAR;
            PG8_LDB(B0, 1, 0); PG8_SCHED; PG8_LDA(At, 1, 0); PG8_STAGE(PG8_SA(0, 1), a2 + hstep, voffA);
            PG8_WAIT_L(8); PG8_BAR; PG8_WAIT_L(0); PG8_MMA(0, 0, At, B0); PG8_BAR; PG8_SCHED;
            PG8_LDB(B1, 1, 1); PG8_STAGE(PG8_SB(1, 0), b3, voffB);
            PG8_BAR; PG8_WAIT_L(0); PG8_MMA(0, 1, At, B1); PG8_BAR;
            PG8_LDA(At, 1, 1); PG8_STAGE(PG8_SA(1, 0), a3, voffA);
            PG8_BAR; PG8_WAIT_L(0); PG8_MMA(1, 0, At, B0); PG8_BAR; PG8_SCHED;
            PG8_STAGE(PG8_SB(1, 1), b3 + hstep, voffB);
            PG8_WAIT_V(6); PG8_BAR; PG8_MMA(1, 1, At, B1); PG8_BAR;
            }
        }
        if constexpr (ALIGN_EPI) { if (wr == 0) PG8_BAR; }
        if constexpr (!Epi::AFTER_DRAIN) { E(acc, cur, wr, wc, fr, fq); S.done(cur); }
        if (!has_next) break;
        E.init(acc, nxt, wr, wc, fr, fq);
        cur = nxt; cA = nA; cB = nB; ++ui;
        if constexpr (ALIGN_EPI) { if (wr == 1) PG8_BAR; }
    }
    PG8_WAIT_V(0);
    if constexpr (!ALIGN_EPI) { if (wr == 0) PG8_BAR; }
    PG8_BAR;
    if constexpr (Epi::AFTER_DRAIN) { E.fused(acc, cur, wr, wc, fr, fq, lds, wid, lane); S.done(cur); }
#undef PG8_SA
#undef PG8_SB
#undef PG8_STAGE
#undef PG8_LDA
#undef PG8_LDB
#undef PG8_MMA
#undef PG8_WAIT_V
#undef PG8_WAIT_L
#undef PG8_BAR
#undef PG8_SCHED
}
}
#define GAS __attribute__((address_space(1)))
#define LAS __attribute__((address_space(3)))
typedef unsigned v4u __attribute__((ext_vector_type(4)));
typedef float f32x4 __attribute__((ext_vector_type(4)));
typedef short bf16x8 __attribute__((ext_vector_type(8)));
typedef GAS unsigned gu32;
typedef GAS unsigned long long gu64;
#define RLX_AGENT __ATOMIC_RELAXED, __HIP_MEMORY_SCOPE_AGENT
#define LDS_WAIT() asm volatile("s_waitcnt lgkmcnt(0)" ::: "memory")
#define VM_WAIT() asm volatile("s_waitcnt vmcnt(0)" ::: "memory")
__device__ __forceinline__ unsigned long long rt() { return __builtin_amdgcn_s_memrealtime(); }
__device__ __forceinline__ unsigned pk2(float lo, float hi) { return f2bf(lo) | (f2bf(hi) << 16); }

#define XB_TMO      128
#define XB_XCNT(j)  (256  + 64 * (j))
#define XB_XSUB(j)  (1280 + 64 * (j))
#define XB_XGEN(j)  (2304 + 64 * (j))
#define XB_TOP      3328
#define XB_TOPGEN   3392
#define XCD_BAR_WORDS 3456
#define XB_SPIN_CAP (1u << 18)

__device__ __forceinline__ unsigned xb_ld(unsigned* p)              { return __hip_atomic_load(p, __ATOMIC_RELAXED, __HIP_MEMORY_SCOPE_AGENT); }
__device__ __forceinline__ unsigned xb_add(unsigned* p, unsigned v) { return __hip_atomic_fetch_add(p, v, __ATOMIC_RELAXED, __HIP_MEMORY_SCOPE_AGENT); }
__device__ __forceinline__ unsigned xb_xcc_id() { return (unsigned)__builtin_amdgcn_s_getreg((3 << 11) | 20) & 0xFu; }
#define XB_SPIN(cond, bar) do { unsigned _sp = 0; while (cond) { __builtin_amdgcn_s_sleep(1); \
    if ((++_sp & 255u) == 0u) { if (xb_ld(&(bar)[XB_TMO])) break; if (_sp > XB_SPIN_CAP) { atomicAdd(&(bar)[XB_TMO], 1u); break; } } } } while (0)

struct XcdBarrier {
    unsigned* bar; unsigned x;
    volatile LAS unsigned* st;
};

__device__ __forceinline__ XcdBarrier xcd_barrier_post(unsigned* bar, volatile LAS unsigned* st) {
    XcdBarrier b; b.bar = bar; b.x = xb_xcc_id(); b.st = st;
    if (threadIdx.x == 0) (void)xb_add(&bar[XB_XCNT(b.x)], 1u);
    return b;
}
__device__ __forceinline__ void xcd_barrier_complete(unsigned* bar, unsigned x, unsigned& nloc, unsigned& nx) {
    const unsigned G = gridDim.x * gridDim.y * gridDim.z;
    unsigned sum, cnt, mine, sp = 0u;
    for (;;) {
        sum = 0u; cnt = 0u; mine = 0u;
#pragma unroll
        for (unsigned j = 0; j < 16; ++j) { const unsigned c = xb_ld(&bar[XB_XCNT(j)]); sum += c; cnt += (c > 0u) ? 1u : 0u; mine = (j == x) ? c : mine; }
        if (sum == G) break;
        __builtin_amdgcn_s_sleep(1);
        if ((++sp & 255u) == 0u) { if (xb_ld(&bar[XB_TMO])) break; if (sp > XB_SPIN_CAP) { atomicAdd(&bar[XB_TMO], 1u); break; } }
    }
    nloc = mine > 0u ? mine : 1u; nx = cnt > 0u ? cnt : 1u;
}

__device__ __forceinline__ void xcd_barrier(const XcdBarrier& b) {
    asm volatile("s_waitcnt vmcnt(0)" ::: "memory");
    __syncthreads();
    if (threadIdx.x == 0) {
        unsigned* bar = b.bar;
        __builtin_amdgcn_s_waitcnt(0);
        unsigned nloc = b.st[0], nx = b.st[1];
        if (nloc == 0u) { xcd_barrier_complete(bar, b.x, nloc, nx); b.st[0] = nloc; b.st[1] = nx; }
        const unsigned old = xb_add(&bar[XB_XSUB(b.x)], 1u);
        const unsigned gen = old / nloc;
        if (old + 1u == (gen + 1u) * nloc) {
            __builtin_amdgcn_fence(__ATOMIC_RELEASE, "agent");
            asm volatile("s_waitcnt vmcnt(0)" ::: "memory");
            const unsigned og = xb_add(&bar[XB_TOP], 1u);
            const unsigned tg = og / nx;
            if (og + 1u == (tg + 1u) * nx) xb_add(&bar[XB_TOPGEN], 1u);
            else XB_SPIN(xb_ld(&bar[XB_TOPGEN]) == tg, bar);
            __builtin_amdgcn_fence(__ATOMIC_ACQUIRE, "agent");
            xb_add(&bar[XB_XGEN(b.x)], 1u);
            asm volatile("s_waitcnt vmcnt(0)" ::: "memory");
        } else {
            XB_SPIN(xb_ld(&bar[XB_XGEN(b.x)]) == gen, bar);
            __builtin_amdgcn_fence(__ATOMIC_ACQUIRE, "agent");
            asm volatile("s_waitcnt vmcnt(0)" ::: "memory");
        }
    }
    __syncthreads();
}

typedef float f32x16 __attribute__((ext_vector_type(16)));
typedef short s16x4 __attribute__((ext_vector_type(4)));
typedef unsigned u32x2a __attribute__((ext_vector_type(2)));
typedef float f32x2_t __attribute__((ext_vector_type(2))); typedef __bf16 bf16x2_t __attribute__((ext_vector_type(2)));
__device__ __forceinline__ unsigned cvtpk(float lo, float hi) { f32x2_t v = {lo, hi}; bf16x2_t b = __builtin_convertvector(v, bf16x2_t); return __builtin_bit_cast(unsigned, b); }
__device__ __forceinline__ int crow(int reg, int h) { return (reg & 3) + 8 * (reg >> 2) + 4 * h; }
__device__ __forceinline__ s16x4 vtr(LAS unsigned char* p) { return __builtin_bit_cast(s16x4, __builtin_amdgcn_ds_read_tr16_b64_v4i16((LAS s16x4*)p)); }
#define LDS_BARRIER() do { asm volatile("s_waitcnt lgkmcnt(0)" ::: "memory"); __builtin_amdgcn_s_barrier(); asm volatile("" ::: "memory"); } while (0)
constexpr int ATT_RS = 144;
constexpr float LOG2E = 1.4426950408889634f;
__device__ __forceinline__ void attn_unit(const Ptrs& p, int l, LAS unsigned char* L, int unit, int tid, int wave, int lane, bool dry) {
    const int b = unit >> 7, kvh = (unit >> 6) & 1, qblk = unit & 63, tok0 = qblk * 128;
    const size_t mrow0 = (size_t)b * T + tok0;
    const GAS bf16* KV = (const GAS bf16*)(p.ws + WS_KV); const GAS bf16* Q = (const GAS bf16*)(p.ws + WS_Q); GAS bf16* ZS = (GAS bf16*)(p.ws + WS_ZS);
    LAS unsigned char* Ks = L; LAS unsigned char* Vs = L + 256 * ATT_RS;
    const int r = lane & 31, h = lane >> 5, g = wave >> 1, qh = wave & 1, head = kvh * 4 + g;
    bf16x8 qfa[2][4]; u32x2a zg[2][2][4];
#pragma unroll
    for (int st = 0; st < 2; ++st) { const size_t mq = mrow0 + qh * 64 + st * 32 + r;
#pragma unroll
        for (int s = 0; s < 4; ++s) qfa[st][s] = *(const GAS bf16x8*)(Q + mq * AW + head * 64 + 16 * s + 8 * h);
#pragma unroll
        for (int dt = 0; dt < 2; ++dt)
#pragma unroll
            for (int gq = 0; gq < 4; ++gq) zg[st][dt][gq] = *(const GAS u32x2a*)(ZS + mq * AW + head * 64 + 32 * dt + 8 * gq + 4 * h); }
#pragma unroll
    for (int i = 0; i < 4; ++i) { const int c = tid + 512 * i, row = c >> 3, ch = c & 7, tok = tok0 - 128 + row;
        v4u kv = {0u, 0u, 0u, 0u}, vv = {0u, 0u, 0u, 0u};
        if (tok >= 0) { const GAS bf16* src = KV + ((size_t)b * T + tok) * 256 + kvh * 64 + ch * 8; kv = *(const GAS v4u*)src; vv = *(const GAS v4u*)(src + 128); }
        *(LAS v4u*)(Ks + row * ATT_RS + ch * 16) = kv; *(LAS v4u*)(Vs + row * ATT_RS + ch * 16) = vv; }
    LDS_BARRIER();
    const float sinkl = p.sinks[l * NH + head] * LOG2E;
#pragma unroll
    for (int st = 0; st < 2; ++st) {
        const int q0 = qh * 64 + st * 32, kt0 = q0 >> 5;
        const size_t mq = mrow0 + q0 + r;
        bf16x8 qf[4];
#pragma unroll
        for (int s = 0; s < 4; ++s) qf[s] = qfa[st][s];
        f32x16 S[5];
        {
            bf16x8 kf[2][4];
#pragma unroll
            for (int s = 0; s < 4; ++s) kf[0][s] = *(const LAS bf16x8*)(Ks + (32 * kt0 + r) * ATT_RS + (16 * s + 8 * h) * 2);
#pragma unroll
            for (int j = 0; j < 5; ++j) {
                if (j < 4) {
#pragma unroll
                    for (int s = 0; s < 4; ++s) kf[(j + 1) & 1][s] = *(const LAS bf16x8*)(Ks + (32 * (kt0 + j + 1) + r) * ATT_RS + (16 * s + 8 * h) * 2); }
                __builtin_amdgcn_sched_barrier(0);
                f32x16 a = {};
#pragma unroll
                for (int s = 0; s < 4; ++s) a = __builtin_amdgcn_mfma_f32_32x32x16_bf16(kf[j & 1][s], qf[s], a, 0, 0, 0);
                S[j] = a;
                __builtin_amdgcn_sched_barrier(0);
            }
        }
        float mx = sinkl;
#pragma unroll
        for (int j = 0; j < 5; ++j)
#pragma unroll
            for (int e = 0; e < 16; ++e) { const int cr = crow(e, h); bool valid = true;
                if (j == 0) valid = (cr - r >= 1);
                if (j == 4) valid = (cr - r <= 0);
                if (qblk == 0) valid = valid && (q0 + 32 * j + cr >= 128);
                const float t = valid ? S[j][e] * LOG2E : -INFINITY; S[j][e] = t; mx = fmaxf(mx, t); }
        mx = fmaxf(mx, __shfl_xor(mx, 32));
        float sum = 0.f;
#pragma unroll
        for (int j = 0; j < 5; ++j)
#pragma unroll
            for (int e = 0; e < 16; ++e) { const float pv = __builtin_amdgcn_exp2f(S[j][e] - mx); S[j][e] = pv; sum += pv; }
        sum += __shfl_xor(sum, 32); sum += __builtin_amdgcn_exp2f(sinkl - mx);
        f32x16 O[2]; O[0] = f32x16{}; O[1] = f32x16{};
        const int i16 = lane & 15, gg = (lane >> 4) & 1;
        {
            s16x4 vlo[2][2], vhi[2][2];
            LAS unsigned char* vp0 = Vs + (32 * kt0 + 4 * h + (i16 >> 2)) * ATT_RS + (16 * gg + 4 * (i16 & 3)) * 2;
#pragma unroll
            for (int dt = 0; dt < 2; ++dt) { vlo[0][dt] = vtr(vp0 + 64 * dt); vhi[0][dt] = vtr(vp0 + 64 * dt + 8 * ATT_RS); }
#pragma unroll
            for (int st2 = 0; st2 < 10; ++st2) { const int j = st2 >> 1, s2 = st2 & 1;
                if (st2 < 9) { LAS unsigned char* vp = vp0 + (16 * (st2 + 1)) * ATT_RS;
#pragma unroll
                    for (int dt = 0; dt < 2; ++dt) { vlo[(st2 + 1) & 1][dt] = vtr(vp + 64 * dt); vhi[(st2 + 1) & 1][dt] = vtr(vp + 64 * dt + 8 * ATT_RS); } }
                __builtin_amdgcn_sched_barrier(0);
                v4u pw; pw.x = cvtpk(S[j][8 * s2 + 0], S[j][8 * s2 + 1]); pw.y = cvtpk(S[j][8 * s2 + 2], S[j][8 * s2 + 3]); pw.z = cvtpk(S[j][8 * s2 + 4], S[j][8 * s2 + 5]); pw.w = cvtpk(S[j][8 * s2 + 6], S[j][8 * s2 + 7]);
                const bf16x8 pb = __builtin_bit_cast(bf16x8, pw);
#pragma unroll
                for (int dt = 0; dt < 2; ++dt) { const s16x4 lo = vlo[st2 & 1][dt], hi = vhi[st2 & 1][dt];
                    const bf16x8 af = {lo[0], lo[1], lo[2], lo[3], hi[0], hi[1], hi[2], hi[3]};
                    O[dt] = __builtin_amdgcn_mfma_f32_32x32x16_bf16(af, pb, O[dt], 0, 0, 0); }
                __builtin_amdgcn_sched_barrier(0);
            }
        }
        const float inv = 1.f / sum;
#pragma unroll
        for (int dt = 0; dt < 2; ++dt)
#pragma unroll
            for (int gq = 0; gq < 4; ++gq) { GAS bf16* zp = ZS + mq * AW + head * 64 + 32 * dt + 8 * gq + 4 * h;
                const u32x2a z = zg[st][dt][gq];
                const float z0 = __builtin_bit_cast(float, z.x << 16), z1 = __builtin_bit_cast(float, z.x & 0xffff0000u), z2 = __builtin_bit_cast(float, z.y << 16), z3 = __builtin_bit_cast(float, z.y & 0xffff0000u);
                u32x2a o; o.x = cvtpk(O[dt][4 * gq + 0] * inv * z0, O[dt][4 * gq + 1] * inv * z1); o.y = cvtpk(O[dt][4 * gq + 2] * inv * z2, O[dt][4 * gq + 3] * inv * z3);
                if (!dry) *(GAS u32x2a*)zp = o; }
        __builtin_amdgcn_sched_barrier(0);
    }
    LDS_BARRIER();
}
__device__ __forceinline__ void attn_phase(const Ptrs& p, int l, LAS unsigned char* L, int vcu, int G, int tid, int wave, int lane, bool dry) {
    constexpr int NU = BATCH * NKV * (T / 128);
    const int upc = (NU + G - 1) / G;
#pragma unroll 1
    for (int i = 0; i < upc; ++i) { const int unit = vcu * upc + i; if (unit < NU) attn_unit(p, l, L, unit, tid, wave, lane, dry); }
}

typedef float f32x2v __attribute__((ext_vector_type(2))); typedef unsigned u32x2v __attribute__((ext_vector_type(2)));
__device__ __forceinline__ float bflo(unsigned w) { return __builtin_bit_cast(float, w << 16); }
__device__ __forceinline__ float bfhi(unsigned w) { return __builtin_bit_cast(float, w & 0xffff0000u); }
constexpr int H_RS = 272, H_RT = 144;
constexpr int HO_QA = 0, HO_KD = HO_QA + 64 * H_RS, HO_KBT = HO_KD + 64 * H_RS, HO_VT = HO_KBT + 128 * H_RT, HO_E = HO_VT + 128 * H_RT, HSET = HO_E + 2048, HO_RED = 2 * HSET, HO_END = HO_RED + 2048;
#define row_ror(x, n) __builtin_bit_cast(float, __builtin_amdgcn_update_dpp(0, __builtin_bit_cast(int, (float)(x)), 0x120 + (n), 0xf, 0xf, false))
template <bool FULL>
__device__ __forceinline__ void hgrn_unit(const Ptrs& p, int l, LAS unsigned char* L, int unit, int tid, int wave, int lane, bool dry) {
    const int seq = unit >> 4, sc = unit & 15, b = seq >> 2, h = seq & 3, cb = h * 128;
    const size_t m0 = (size_t)b * T + sc * 512;
    const GAS unsigned short* LOGF = (const GAS unsigned short*)(p.ws + WS_LOGF);
    const GAS bf16* QH = (const GAS bf16*)(p.ws + WS_QH); const GAS bf16* IH = (const GAS bf16*)(p.ws + WS_IH); GAS bf16* GS = (GAS bf16*)(p.ws + WS_GS);
    GAS float* HS = (GAS float*)(p.ws + WS_HS); GAS float* HD = (GAS float*)(p.ws + WS_HD);
    if (wave < 4) {
        const int d0 = 2 * (tid & 63), isb = tid >> 6;
        unsigned lfX[16], vX[16], qX[16], lfY[16], vY[16], qY[16];
        float gtot0 = 0.f, gtot1 = 0.f;
#define HG_LOAD(cc, LF, VV, QQ) do { const size_t mc_ = m0 + (cc) * 64; \
            _Pragma("unroll") for (int e = 0; e < 16; ++e) { const size_t off = (mc_ + 16 * isb + e) * HW + cb + d0; \
                LF[e] = *(const GAS unsigned*)(LOGF + off); VV[e] = *(const GAS unsigned*)(IH + off); QQ[e] = FULL ? *(const GAS unsigned*)(QH + off) : 0u; } } while (0)
#define HG_BUILD(sb, LF, VV, QQ) do { float cs0[16], cs1[16], kin0[16], kin1[16]; float run0 = 0.f, run1 = 0.f; \
            _Pragma("unroll") for (int e = 0; e < 16; ++e) { typedef _Float16 f16x2_ __attribute__((ext_vector_type(2))); const f16x2_ hv = __builtin_bit_cast(f16x2_, LF[e]); \
                const float l0 = (float)hv[0], l1 = (float)hv[1]; run0 += l0; run1 += l1; cs0[e] = run0; cs1[e] = run1; kin0[e] = 1.f - pg8::fexp(l0); kin1[e] = 1.f - pg8::fexp(l1); } \
            unsigned kb0[8], kb1[8], vt0[8], vt1[8]; \
            _Pragma("unroll") for (int e = 0; e < 16; ++e) { const int t = 16 * isb + e; \
                const unsigned kbp = cvtpk(kin0[e] * pg8::fexp(run0 - cs0[e]), kin1[e] * pg8::fexp(run1 - cs1[e])); \
                if (e & 1) { kb0[e >> 1] |= kbp << 16; kb1[e >> 1] |= kbp & 0xffff0000u; vt0[e >> 1] |= VV[e] << 16; vt1[e >> 1] |= VV[e] & 0xffff0000u; } \
                else { kb0[e >> 1] = kbp & 0xffffu; kb1[e >> 1] = kbp >> 16; vt0[e >> 1] = VV[e] & 0xffffu; vt1[e >> 1] = VV[e] >> 16; } \
                if (FULL) { const float q0 = bflo(QQ[e]), q1 = bfhi(QQ[e]); \
                    *(LAS unsigned*)(L + (sb) + HO_QA + t * H_RS + d0 * 2) = cvtpk(q0 * pg8::fexp(cs0[e]), q1 * pg8::fexp(cs1[e])); \
                    *(LAS unsigned*)(L + (sb) + HO_KD + t * H_RS + d0 * 2) = cvtpk(kin0[e] * pg8::fexp(fminf(-cs0[e], 80.f)), kin1[e] * pg8::fexp(fminf(-cs1[e], 80.f))); } } \
            *(LAS v4u*)(L + (sb) + HO_KBT + d0 * H_RT + 32 * isb) = (v4u){kb0[0], kb0[1], kb0[2], kb0[3]}; *(LAS v4u*)(L + (sb) + HO_KBT + d0 * H_RT + 32 * isb + 16) = (v4u){kb0[4], kb0[5], kb0[6], kb0[7]}; \
            *(LAS v4u*)(L + (sb) + HO_KBT + (d0 + 1) * H_RT + 32 * isb) = (v4u){kb1[0], kb1[1], kb1[2], kb1[3]}; *(LAS v4u*)(L + (sb) + HO_KBT + (d0 + 1) * H_RT + 32 * isb + 16) = (v4u){kb1[4], kb1[5], kb1[6], kb1[7]}; \
            *(LAS v4u*)(L + (sb) + HO_VT + d0 * H_RT + 32 * isb) = (v4u){vt0[0], vt0[1], vt0[2], vt0[3]}; *(LAS v4u*)(L + (sb) + HO_VT + d0 * H_RT + 32 * isb + 16) = (v4u){vt0[4], vt0[5], vt0[6], vt0[7]}; \
            *(LAS v4u*)(L + (sb) + HO_VT + (d0 + 1) * H_RT + 32 * isb) = (v4u){vt1[0], vt1[1], vt1[2], vt1[3]}; *(LAS v4u*)(L + (sb) + HO_VT + (d0 + 1) * H_RT + 32 * isb + 16) = (v4u){vt1[4], vt1[5], vt1[6], vt1[7]}; \
            *(LAS f32x2v*)(L + (sb) + HO_E + (isb * 128 + d0) * 4) = (f32x2v){pg8::fexp(run0), pg8::fexp(run1)}; gtot0 += run0; gtot1 += run1; } while (0)
        HG_LOAD(0, lfX, vX, qX);
        HG_LOAD(1, lfY, vY, qY);
        HG_BUILD(0, lfX, vX, qX);
        HG_LOAD(2, lfX, vX, qX);
        LDS_BARRIER();
#pragma unroll 1
        for (int c = 0; c < 8; c += 2) {
            HG_BUILD(HSET, lfY, vY, qY);
            if (c + 3 < 8) HG_LOAD(c + 3, lfY, vY, qY);
            if (FULL) LDS_BARRIER();
            LDS_BARRIER();
            if (c + 2 < 8) { HG_BUILD(0, lfX, vX, qX); if (c + 4 < 8) HG_LOAD(c + 4, lfX, vX, qX); }
            if (FULL) LDS_BARRIER();
            LDS_BARRIER();
        }
#undef HG_LOAD
#undef HG_BUILD
        if (!FULL) {
            *(LAS f32x2v*)(L + HO_RED + (isb * 128 + d0) * 4) = (f32x2v){gtot0, gtot1};
            LDS_BARRIER();
            if (isb == 0) { f32x2v t4 = *(const LAS f32x2v*)(L + HO_RED + d0 * 4);
#pragma unroll
                for (int k = 1; k < 4; ++k) t4 += *(const LAS f32x2v*)(L + HO_RED + (k * 128 + d0) * 4);
                *(GAS f32x2v*)(HD + unit * 128 + d0) = (f32x2v){pg8::fexp(t4.x), pg8::fexp(t4.y)}; }
            LDS_BARRIER();
        }
    } else {
        const int cw = wave - 4, fr = lane & 15, g = lane >> 4;
        __builtin_amdgcn_s_setprio(2);
        f32x4 S[2][8];
#pragma unroll
        for (int s2 = 0; s2 < 2; ++s2)
#pragma unroll
            for (int kt = 0; kt < 8; ++kt) S[s2][kt] = (f32x4){0.f, 0.f, 0.f, 0.f};
        if (FULL && sc > 0) { const GAS float* HSS = (const GAS float*)(p.ws + WS_HSS);
#pragma unroll
            for (int s2 = 0; s2 < 2; ++s2)
#pragma unroll
                for (int kt = 0; kt < 8; ++kt)
#pragma unroll
                    for (int e = 0; e < 4; ++e) S[s2][kt][e] = HSS[((size_t)(unit * 8 + 2 * cw + s2) * 32 + kt * 4 + e) * 64 + lane]; }
        float nw[2]; unsigned short gsc[2][4][4];
#pragma unroll
        for (int s2 = 0; s2 < 2; ++s2) nw[s2] = FULL ? p.hnw[l * HDK + 16 * (2 * cw + s2) + fr] : 0.f;
#define HG_LOADG(cc) do { const size_t mc_ = m0 + (cc) * 64; \
            if (FULL) { _Pragma("unroll") for (int s2 = 0; s2 < 2; ++s2) _Pragma("unroll") for (int i = 0; i < 4; ++i) _Pragma("unroll") for (int e = 0; e < 4; ++e) \
                gsc[s2][i][e] = GS[(mc_ + 16 * i + 4 * g + e) * HW + cb + 16 * (2 * cw + s2) + fr]; } } while (0)
        LDS_BARRIER();
#pragma unroll 1
        for (int c = 0; c < 8; ++c) {
            const size_t mc = m0 + c * 64; const int sb = (c & 1) * HSET;
            f32x4 o[2][4];
#pragma unroll
            for (int i = 0; i < 4; ++i) {
                u32x2v v2[2];
#pragma unroll
                for (int s2 = 0; s2 < 2; ++s2) v2[s2] = *(const LAS u32x2v*)(L + sb + HO_VT + (16 * (2 * cw + s2) + fr) * H_RT + (16 * i + 4 * g) * 2);
                bf16x8 ka[4], qb[4]; u32x2v qlo[4], qhi[4]; u32x2v k2[2]; f32x4 ge[2];
                if (FULL) {
#pragma unroll
                    for (int ks = 0; ks < 4; ++ks) { ka[ks] = *(const LAS bf16x8*)(L + sb + HO_KD + (16 * i + fr) * H_RS + 16 * g + 64 * ks); qb[ks] = *(const LAS bf16x8*)(L + sb + HO_QA + (16 * i + fr) * H_RS + 16 * g + 64 * ks); }
#pragma unroll
                    for (int u = 0; u < 4; ++u) { qlo[u] = *(const LAS u32x2v*)(L + sb + HO_QA + (16 * i + fr) * H_RS + (32 * u + 4 * g) * 2); qhi[u] = *(const LAS u32x2v*)(L + sb + HO_QA + (16 * i + fr) * H_RS + (32 * u + 16 + 4 * g) * 2); }
                }
                __builtin_amdgcn_sched_barrier(0);
                bf16x8 vb[2];
#pragma unroll
                for (int s2 = 0; s2 < 2; ++s2) vb[s2] = __builtin_bit_cast(bf16x8, (v4u){v2[s2].x, v2[s2].y, 0u, 0u});
                if (FULL) {
                    f32x4 cacc = {0.f, 0.f, 0.f, 0.f};
#pragma unroll
                    for (int ks = 0; ks < 4; ++ks) cacc = __builtin_amdgcn_mfma_f32_16x16x32_bf16(ka[ks], qb[ks], cacc, 0, 0, 0);
#pragma unroll
                    for (int e = 0; e < 4; ++e) if (4 * g + e > fr) cacc[e] = 0.f;
                    const bf16x8 pa = __builtin_bit_cast(bf16x8, (v4u){cvtpk(cacc[0], cacc[1]), cvtpk(cacc[2], cacc[3]), 0u, 0u});
                    __builtin_amdgcn_sched_barrier(0);
#pragma unroll
                    for (int kt = 0; kt < 2; ++kt) { k2[kt] = *(const LAS u32x2v*)(L + sb + HO_KBT + (16 * kt + fr) * H_RT + (16 * i + 4 * g) * 2); ge[kt] = *(const LAS f32x4*)(L + sb + HO_E + (i * 128 + 16 * kt + 4 * g) * 4); }
                    __builtin_amdgcn_sched_barrier(0);
#pragma unroll
                    for (int s2 = 0; s2 < 2; ++s2) {
                        f32x4 a = __builtin_amdgcn_mfma_f32_16x16x32_bf16(pa, vb[s2], (f32x4){0.f, 0.f, 0.f, 0.f}, 0, 0, 0);
#pragma unroll
                        for (int u = 0; u < 4; ++u) { const bf16x8 qa = __builtin_bit_cast(bf16x8, (v4u){qlo[u].x, qlo[u].y, qhi[u].x, qhi[u].y});
                            const bf16x8 sbv = __builtin_bit_cast(bf16x8, (v4u){cvtpk(S[s2][2 * u][0], S[s2][2 * u][1]), cvtpk(S[s2][2 * u][2], S[s2][2 * u][3]), cvtpk(S[s2][2 * u + 1][0], S[s2][2 * u + 1][1]), cvtpk(S[s2][2 * u + 1][2], S[s2][2 * u + 1][3])});
                            a = __builtin_amdgcn_mfma_f32_16x16x32_bf16(qa, sbv, a, 0, 0, 0); }
                        o[s2][i] = a; }
                } else {
#pragma unroll
                    for (int kt = 0; kt < 2; ++kt) { k2[kt] = *(const LAS u32x2v*)(L + sb + HO_KBT + (16 * kt + fr) * H_RT + (16 * i + 4 * g) * 2); ge[kt] = *(const LAS f32x4*)(L + sb + HO_E + (i * 128 + 16 * kt + 4 * g) * 4); }
                }
#pragma unroll
                for (int pr = 0; pr < 4; ++pr) {
                    u32x2v k2n[2]; f32x4 gen[2];
                    if (pr < 3) {
#pragma unroll
                        for (int kt = 0; kt < 2; ++kt) { k2n[kt] = *(const LAS u32x2v*)(L + sb + HO_KBT + (16 * (2 * pr + 2 + kt) + fr) * H_RT + (16 * i + 4 * g) * 2); gen[kt] = *(const LAS f32x4*)(L + sb + HO_E + (i * 128 + 16 * (2 * pr + 2 + kt) + 4 * g) * 4); } }
                    __builtin_amdgcn_sched_barrier(0);
#pragma unroll
                    for (int kt = 0; kt < 2; ++kt) { const bf16x8 kb8 = __builtin_bit_cast(bf16x8, (v4u){k2[kt].x, k2[kt].y, 0u, 0u});
#pragma unroll
                        for (int s2 = 0; s2 < 2; ++s2) S[s2][2 * pr + kt] = __builtin_amdgcn_mfma_f32_16x16x32_bf16(kb8, vb[s2], S[s2][2 * pr + kt] * ge[kt], 0, 0, 0); }
                    if (pr < 3) {
#pragma unroll
                        for (int kt = 0; kt < 2; ++kt) { k2[kt] = k2n[kt]; ge[kt] = gen[kt]; } }
                    __builtin_amdgcn_sched_barrier(0);
                }
            }
            if (FULL) {
                HG_LOADG(c);
                f32x4 sq[4];
#pragma unroll
                for (int i = 0; i < 4; ++i) { sq[i] = o[0][i] * o[0][i] + o[1][i] * o[1][i];
#pragma unroll
                    for (int e = 0; e < 4; ++e) { sq[i][e] += row_ror(sq[i][e], 8); }
#pragma unroll
                    for (int e = 0; e < 4; ++e) { sq[i][e] += row_ror(sq[i][e], 4); }
#pragma unroll
                    for (int e = 0; e < 4; ++e) { sq[i][e] += row_ror(sq[i][e], 2); }
#pragma unroll
                    for (int e = 0; e < 4; ++e) { sq[i][e] += row_ror(sq[i][e], 1); } }
                if (fr == 0) {
#pragma unroll
                    for (int i = 0; i < 4; ++i) *(LAS f32x4*)(L + HO_RED + (cw * 64 + 16 * i + 4 * g) * 4) = sq[i]; }
                LDS_BARRIER();
#pragma unroll
                for (int i = 0; i < 4; ++i) { f32x4 tot = *(const LAS f32x4*)(L + HO_RED + (16 * i + 4 * g) * 4);
#pragma unroll
                    for (int ww = 1; ww < 4; ++ww) tot += *(const LAS f32x4*)(L + HO_RED + (ww * 64 + 16 * i + 4 * g) * 4);
#pragma unroll
                    for (int e = 0; e < 4; ++e) { const int t = 16 * i + 4 * g + e;
                        const float rs = __builtin_amdgcn_rsqf(tot[e] * (1.f / HDK) + EPS);
#pragma unroll
                        for (int s2 = 0; s2 < 2; ++s2) { const bf16 ov = (bf16)cvtpk(o[s2][i][e] * rs * nw[s2] * bf2f(gsc[s2][i][e]), 0.f); if (!dry) GS[(mc + t) * HW + cb + 16 * (2 * cw + s2) + fr] = ov; } } }
            }
            LDS_BARRIER();
        }
#undef HG_LOADG
        if (!FULL) {
#pragma unroll
            for (int s2 = 0; s2 < 2; ++s2)
#pragma unroll
                for (int kt = 0; kt < 8; ++kt)
#pragma unroll
                    for (int e = 0; e < 4; ++e) HS[((size_t)(unit * 8 + 2 * cw + s2) * 32 + kt * 4 + e) * 64 + lane] = S[s2][kt][e];
            LDS_BARRIER();
            LDS_BARRIER();
        }
        __builtin_amdgcn_s_setprio(0);
    }
}
__device__ __forceinline__ void hgrn_scan_phase(const Ptrs& p, int vcu, int G, int tid) {
    const GAS float* HS = (const GAS float*)(p.ws + WS_HS); const GAS float* HD = (const GAS float*)(p.ws + WS_HD); GAS float* HSS = (GAS float*)(p.ws + WS_HSS);
#pragma unroll 1
    for (int it = vcu * 512 + tid; it < BATCH * HH * 16384; it += G * 512) {
        const int seq = it >> 14, idx = it & 16383, r = (idx >> 6) & 31, ln = idx & 63, dk = 16 * (r >> 2) + 4 * (ln >> 4) + (r & 3);
        float ds[15], dd[15];
#pragma unroll
        for (int j = 0; j < 15; ++j) { const int uj = seq * 16 + j; ds[j] = HS[(size_t)uj * 16384 + idx]; dd[j] = HD[uj * 128 + dk]; }
        float s = 0.f;
#pragma unroll
        for (int j = 0; j < 15; ++j) { s = s * dd[j] + ds[j]; HSS[(size_t)(seq * 16 + j + 1) * 16384 + idx] = s; }
    }
}
template <bool FULL>
__device__ __forceinline__ void hgrn_phase(const Ptrs& p, int l, LAS unsigned char* L, int vcu, int G, int tid, int wave, int lane, bool dry) {
    constexpr int NU = BATCH * HH * (T / 512);
#pragma unroll 1
    for (int unit = vcu; unit < NU; unit += G) hgrn_unit<FULL>(p, l, L, unit, tid, wave, lane, dry);
}


constexpr int NWAVES = 8;
constexpr int RING_OFF = 0, RING_BYTES = 155648;
constexpr int LDSCTL_OFF = RING_BYTES, MISC_OFF = LDSCTL_OFF + 320;
constexpr int LDS_BYTES = 163840;
static_assert(HO_END <= RING_BYTES, "HGRN LDS map");
constexpr int CW_BAR = 4096;
constexpr size_t CTL_ZERO_BYTES = 192 * 1024;
constexpr int NPHASE = 13;
static_assert((CW_BAR + XCD_BAR_WORDS) * 4 <= 131072 && 131072 + 128 * 256 <= (int)CTL_ZERO_BYTES, "barrier words and panel counters inside the memset region (one launch: barrier region 0 only)");

#ifndef MK_PROBES
#define MK_PROBES 0
#endif
static_assert(DEPTH == 2, "the out-projection epilogue distinguishes only a first and a last layer");
struct Args { Ptrs p; int ph_lo, ph_hi, li, probe; };

__device__ __forceinline__ float wave_sum(float v) {
#pragma unroll
    for (int o = 1; o < 64; o <<= 1) v += __shfl_xor(v, o);
    return v;
}
__device__ __forceinline__ void p0_transpose_item(const float* W, int K, int N, bf16* WT, LAS float* scr, int item, int lane, const float* kscale, bool permute) {
    const int nblk = N / 32, kb = item / nblk, nb = item % nblk, k0 = 64 * kb, n0 = 32 * nb;
    const int nsrc = permute ? src_col(n0 + (lane & 31)) : n0 + (lane & 31);
    float wv[32];
#pragma unroll
    for (int i = 0; i < 32; ++i) wv[i] = W[(size_t)(k0 + 2 * i + (lane >> 5)) * N + nsrc];
#pragma unroll
    for (int i = 0; i < 32; ++i) { const int kk = 2 * i + (lane >> 5); float v = wv[i]; if (kscale) v *= kscale[k0 + kk]; scr[kk * 33 + (lane & 31)] = v; }
    LDS_WAIT(); asm volatile("" ::: "memory");
    const int c = lane & 7;
#pragma unroll
    for (int j = 0; j < 4; ++j) { const int n = (lane >> 3) + 8 * j; const LAS float* s = scr + (8 * c) * 33 + n;
        v4u o; o.x = pk2(s[0 * 33], s[1 * 33]); o.y = pk2(s[2 * 33], s[3 * 33]); o.z = pk2(s[4 * 33], s[5 * 33]); o.w = pk2(s[6 * 33], s[7 * 33]);
        *(GAS v4u*)(WT + (size_t)(n0 + n) * K + k0 + 8 * c) = o; }
    LDS_WAIT(); asm volatile("" ::: "memory");
}
__device__ __forceinline__ double inv_freq_d(int f) {
    return f == 0 ? 1.0 : f == 1 ? 0.19392274474868576 : f == 2 ? 0.03760603093086393 : f == 3 ? 0.007292664737217109 : f == 4 ? 0.001414213562373095 : f == 5 ? 0.0002742481756762073 : f == 6 ? 5.318295896944988e-05 : 1.031338537721246e-05;
}
__device__ __forceinline__ void p0_prologue(const Ptrs& p, LAS unsigned char* L, int vcu, int G, int wave, int lane, int tid) {
    LAS float* scr = (LAS float*)(L + RING_OFF + wave * 16384);
    const int gw = vcu * NWAVES + wave, NGW = G * NWAVES;
    constexpr int I_IN = (D / 64) * (NIN / 32), I_U = (AW / 64) * (D / 32), I_O = (D / 64) * (D / 32), I_L = I_IN + 2 * I_U + I_O;
#pragma unroll 1
    for (int st = gw; st < I_L || st * 4 < M; st += NGW) {
        const int m4 = st * 4; const bool rows = m4 < M;
        f32x4 v[4][4];
        if (rows) {
#pragma unroll
            for (int rr = 0; rr < 4; ++rr)
#pragma unroll
                for (int j = 0; j < 4; ++j) v[rr][j] = ((const GAS f32x4*)(p.x + (size_t)(m4 + rr) * D) + lane)[64 * j]; }
        if (st < I_L) {
            const int l = 0; int r = st;
            if (r < I_IN) p0_transpose_item(p.w_in + (size_t)l * D * NIN, D, NIN, (bf16*)(p.ws + WS_WIN) + (size_t)l * NIN * D, scr, r, lane, p.norm_w + l * D, true);
            else if ((r -= I_IN) < I_U) p0_transpose_item(p.w_ua + (size_t)l * AW * D, AW, D, (bf16*)(p.ws + WS_WUA) + (size_t)l * D * AW, scr, r, lane, nullptr, false);
            else if ((r -= I_U) < I_U) p0_transpose_item(p.w_uh + (size_t)l * AW * D, AW, D, (bf16*)(p.ws + WS_WUH) + (size_t)l * D * AW, scr, r, lane, nullptr, false);
            else p0_transpose_item(p.w_out + (size_t)l * D * D, D, D, (bf16*)(p.ws + WS_WOUT) + (size_t)l * D * D, scr, r - I_U, lane, nullptr, false);
        }
        if (rows) {
#pragma unroll
            for (int rr = 0; rr < 4; ++rr) { const int m = m4 + rr;
#pragma unroll
                for (int j = 0; j < 4; ++j) { float s = (v[rr][j][0] * v[rr][j][0] + v[rr][j][1] * v[rr][j][1]) + (v[rr][j][2] * v[rr][j][2] + v[rr][j][3] * v[rr][j][3]);
                    s += __shfl_xor(s, 1); s += __shfl_xor(s, 2); s += __shfl_xor(s, 4); s += __shfl_xor(s, 8);
                    ((GAS unsigned long long*)((bf16*)(p.ws + WS_XB) + (size_t)m * D))[64 * j + lane] = (unsigned long long)pk2(v[rr][j][0], v[rr][j][1]) | ((unsigned long long)pk2(v[rr][j][2], v[rr][j][3]) << 32);
                    if ((lane & 15) == 0) ((float*)(p.ws + WS_SSQ))[(size_t)m * 16 + 4 * j + (lane >> 4)] = s; } }
        }
    }
    for (int i = vcu * (NWAVES * 64) + tid; i < M * 8; i += G * NWAVES * 64) {
        const int m = i >> 3, f = i & 7;
        const double ang = (double)p.pos[m] * inv_freq_d(f);
        const double rev = ang * 0.15915494309189535, fr = rev - __builtin_rint(rev);
        const float a = (float)(fr * 6.283185307179586);
        ((float*)(p.ws + WS_COS))[i] = cosf(a); ((float*)(p.ws + WS_SIN))[i] = sinf(a);
        if (i < HW) { float mx = -1e30f;
            for (int l = 0; l < DEPTH; ++l) mx = fmaxf(mx, p.lb_logits[l * HW + i]);
            float den = 0.f; for (int l = 0; l < DEPTH; ++l) den += pg8::fexp(p.lb_logits[l * HW + i] - mx);
            float acc = 0.f; for (int l = 0; l < DEPTH; ++l) { const float s = pg8::fexp(p.lb_logits[l * HW + i] - mx) / den; if (l > 0) acc += s; ((float*)(p.ws + WS_LB))[l * HW + i] = acc; } }
    }
}
__device__ __forceinline__ void late_weights(const Ptrs& p, LAS unsigned char* L, int wave, int lane, int wv, int nwv) {
    LAS float* scr = (LAS float*)(L + RING_OFF + wave * 16384);
    constexpr int I_IN = (D / 64) * (NIN / 32), I_U = (AW / 64) * (D / 32), I_O = (D / 64) * (D / 32), I_L = I_IN + 2 * I_U + I_O;
#pragma unroll 1
    for (int st = I_L + wv; st < DEPTH * I_L; st += nwv) {
        const int l = st / I_L; int r = st % I_L;
        if (r < I_IN) p0_transpose_item(p.w_in + (size_t)l * D * NIN, D, NIN, (bf16*)(p.ws + WS_WIN) + (size_t)l * NIN * D, scr, r, lane, p.norm_w + l * D, true);
        else if ((r -= I_IN) < I_U) p0_transpose_item(p.w_ua + (size_t)l * AW * D, AW, D, (bf16*)(p.ws + WS_WUA) + (size_t)l * D * AW, scr, r, lane, nullptr, false);
        else if ((r -= I_U) < I_U) p0_transpose_item(p.w_uh + (size_t)l * AW * D, AW, D, (bf16*)(p.ws + WS_WUH) + (size_t)l * D * AW, scr, r, lane, nullptr, false);
        else p0_transpose_item(p.w_out + (size_t)l * D * D, D, D, (bf16*)(p.ws + WS_WOUT) + (size_t)l * D * D, scr, r - I_U, lane, nullptr, false);
    }
}
__device__ __forceinline__ void final_norm_phase(const Ptrs& p, int vcu, int G, int wave, int lane) {
    const int gw = vcu * NWAVES + wave, NGW = G * NWAVES;
    f32x4 w[4];
#pragma unroll
    for (int j = 0; j < 4; ++j) w[j] = ((const f32x4*)p.fnw)[64 * j + lane];
    for (int m = gw; m < M; m += NGW) {
        const f32x4* sp = (const f32x4*)((const float*)(p.ws + WS_SSQ) + (size_t)m * 16);
        const f32x4 a = (sp[0] + sp[1]) + (sp[2] + sp[3]);
        const float r = __builtin_amdgcn_rsqf(((a[0] + a[1]) + (a[2] + a[3])) * (1.f / D) + EPS);
        f32x4* xr = (f32x4*)(p.out + (size_t)m * D) + lane;
#pragma unroll
        for (int j = 0; j < 4; ++j) xr[64 * j] = xr[64 * j] * r * w[j];
    }
}

__global__ void __launch_bounds__(NWAVES * 64, 2) fwd(Args args) {
    extern __shared__ __attribute__((aligned(16))) unsigned char lds[];
    LAS unsigned char* L = (LAS unsigned char*)lds;
    volatile LAS unsigned* MISC = (volatile LAS unsigned*)(L + MISC_OFF);
    const int tid = threadIdx.x, wave = __builtin_amdgcn_readfirstlane(tid >> 6);
    const int G = gridDim.x, bx = blockIdx.x, vcu = (G % 8 == 0) ? (bx % 8) * (G / 8) + bx / 8 : bx;
    const Ptrs& p = args.p; unsigned char* ws = p.ws;
    for (int u = tid; u < (LDS_BYTES - LDSCTL_OFF) / 4; u += NWAVES * 64) ((LAS unsigned*)(L + LDSCTL_OFF))[u] = 0u;
    __syncthreads();
    const int lo = args.ph_lo, hi = args.ph_hi;
    XcdBarrier bar; bar.bar = (unsigned*)(ws + WS_CTL) + CW_BAR + args.li * XCD_BAR_WORDS; bar.x = 0; bar.st = nullptr;
    if (hi - lo > 1) bar = xcd_barrier_post((unsigned*)(ws + WS_CTL) + CW_BAR + args.li * XCD_BAR_WORDS, MISC + 8);
#define IN(k) (lo <= (k) && (k) < hi)
#if MK_PROBES
#define REP(k) _Pragma("unroll 1") for (int rep_ = 0; rep_ < ((k) == args.probe ? 2 : 1); ++rep_)
#define DRY (rep_ != 0)
#define STAMP(i) do { if (args.probe >= 200 && bx == 0 && threadIdx.x == 0) TS[i] = rt(); } while (0)
#else
#define REP(k)
#define DRY false
#define STAMP(i) do { } while (0)
#endif
#define PH_TID int tid_ = threadIdx.x; asm volatile("" : "+v"(tid_)); const int lane_ = tid_ & 63; (void)lane_
#define SEAM(k) do { if (IN(k) && IN((k) + 1)) xcd_barrier(bar); STAMP((k) + 1); } while (0)
#if MK_PROBES
    unsigned long long* TS = (unsigned long long*)(ws + WS_CTL + 65536);
#endif
    STAMP(0);

    if (IN(0)) REP(0) { PH_TID; p0_prologue(p, L, vcu, G, wave, lane_, tid_); }
    SEAM(0);
#pragma unroll 1
    for (int l = 0; l < DEPTH; ++l) {
        const int pb = 1 + 6 * l;
        if (IN(pb)) REP(pb) {
            GAS unsigned char* ws = (GAS unsigned char*)p.ws; asm volatile("" : "+s"(ws));
            pg8::Gemm g{(const bf16*)(ws + WS_XB), (const bf16*)(ws + WS_WIN) + (size_t)l * NIN * D, M, NIN, D, nullptr, nullptr}; pg8::StaticOrder S; S.init(M, NIN, G, bx);
            pg8::EpiInProj E{ws, l, DRY};
            pg8::gemm_phase<pg8::EpiInProj, pg8::StaticOrder, true, true>(L + RING_OFF, g, S, E);
            if (l == 0 && !DRY) {
                constexpr int NUNIT = (M / 256) * (NIN / 256); const int nlong = NUNIT % G;
                if (nlong != 0 ? bx >= nlong : true) { PH_TID; __syncthreads(); late_weights(p, L, wave, lane_, (nlong != 0 ? bx - nlong : bx) * NWAVES + wave, (nlong != 0 ? G - nlong : G) * NWAVES); }
            }
        }
        SEAM(pb);
        if (IN(pb + 1)) REP(pb + 1) {
            Ptrs q = p; asm volatile("" : "+s"(q.ws));
            PH_TID;
            attn_phase(q, l, L + RING_OFF, vcu, G, tid_, wave, lane_, DRY);
            if (l == 0) STAMP(15);
            hgrn_phase<false>(q, l, L + RING_OFF, vcu, G, tid_, wave, lane_, DRY);
        }
        SEAM(pb + 1);
        if (IN(pb + 2)) REP(pb + 2) {
            Ptrs q = p; asm volatile("" : "+s"(q.ws));
            PH_TID; hgrn_scan_phase(q, vcu, G, tid_);
        }
        SEAM(pb + 2);
        if (IN(pb + 3)) REP(pb + 3) {
            Ptrs q = p; asm volatile("" : "+s"(q.ws));
            PH_TID;
            hgrn_phase<true>(q, l, L + RING_OFF, vcu, G, tid_, wave, lane_, DRY);
        }
        SEAM(pb + 3);
        if (IN(pb + 4)) REP(pb + 4) {
            GAS unsigned char* ws = (GAS unsigned char*)p.ws; asm volatile("" : "+s"(ws));
            pg8::Gemm g{(const bf16*)(ws + WS_ZS), (const bf16*)(ws + WS_WUA) + (size_t)l * D * AW, M, D, AW, (const bf16*)(ws + WS_GS), (const bf16*)(ws + WS_WUH) + (size_t)l * D * AW}; pg8::StaticOrder2 S; S.init(M, D, G, bx);
            pg8::EpiUp2 E{ws, DRY};
            pg8::gemm_phase<pg8::EpiUp2, pg8::StaticOrder2, true, true>(L + RING_OFF, g, S, E);
        }
        SEAM(pb + 4);
        if (IN(pb + 5)) REP(pb + 5) {
            GAS unsigned char* ws = (GAS unsigned char*)p.ws; asm volatile("" : "+s"(ws));
            pg8::Gemm g{(const bf16*)(ws + WS_GA), (const bf16*)(ws + WS_WOUT) + (size_t)l * D * D, M, D, D, nullptr, nullptr}; pg8::StaticOrder S; S.init(M, D, G, bx);
            pg8::EpiOut E{ws, (const GAS float*)p.x, (GAS float*)p.out, (const GAS float*)p.fnw, L + 131072, l == DEPTH - 1, DRY};
            pg8::gemm_phase<pg8::EpiOut, pg8::StaticOrder, true, true>(L + RING_OFF, g, S, E);
        }
        SEAM(pb + 5);
    }
#if MK_PROBES
    if (args.probe >= 200 && bx == 0 && threadIdx.x == 0) {
        TS[13] = rt(); const int c = args.probe - 200, ilo = c >> 4, ihi = c & 15;
        const unsigned long long target = 250000ull + (TS[ihi] - TS[ilo]);
        while (rt() - TS[0] < target) __builtin_amdgcn_s_sleep(32);
    }
#endif
#undef REP
#undef DRY
#undef STAMP
#undef PH_TID
#undef IN
#undef SEAM
}

constexpr int PROBE_PHASE = -1;
static void launch_fwd(const Ptrs& p, int lo, int hi, int li, int grid, hipStream_t stream) {
    Args a{}; a.p = p; a.ph_lo = lo; a.ph_hi = hi; a.li = li; a.probe = PROBE_PHASE;
    hipLaunchKernelGGL(fwd, dim3(grid), dim3(NWAVES * 64), LDS_BYTES, stream, a);
}
extern "C" void kernel_launch(void* const* d_in, const int* in_sizes, int n_in, void* d_out, int out_size, void* d_ws, size_t ws_size, hipStream_t stream) {
    static int grid = 0;
    if (grid == 0) {
        if (n_in != 11 || in_sizes[0] != M * D || out_size != M * D || ws_size < WS_END) { fprintf(stderr, "kernel_launch: unexpected shapes / workspace (%d inputs, in0 %d, out %d, ws %zu)\n", n_in, n_in > 0 ? in_sizes[0] : -1, out_size, ws_size); grid = -1; return; }
        int dev = 0, cus = 0, per_cu = 0;
        if (hipGetDevice(&dev) != hipSuccess || hipDeviceGetAttribute(&cus, hipDeviceAttributeMultiprocessorCount, dev) != hipSuccess) { grid = -1; return; }
        if (hipFuncSetAttribute((const void*)fwd, hipFuncAttributeMaxDynamicSharedMemorySize, LDS_BYTES) != hipSuccess) { fprintf(stderr, "kernel_launch: hipFuncSetAttribute failed\n"); grid = -1; return; }
        if (hipOccupancyMaxActiveBlocksPerMultiprocessor(&per_cu, (const void*)fwd, NWAVES * 64, LDS_BYTES) != hipSuccess || per_cu < 1) fprintf(stderr, "kernel_launch: occupancy query reports %d blocks per CU\n", per_cu);
        (void)hipGetLastError();
        grid = cus;
    }
    if (grid < 0) return;
    Ptrs p{};
    p.x = (const float*)d_in[0]; p.pos = (const int*)d_in[1]; p.norm_w = (const float*)d_in[2]; p.w_in = (const float*)d_in[3]; p.sinks = (const float*)d_in[4]; p.hnw = (const float*)d_in[5];
    p.w_ua = (const float*)d_in[6]; p.w_uh = (const float*)d_in[7]; p.w_out = (const float*)d_in[8]; p.lb_logits = (const float*)d_in[9]; p.fnw = (const float*)d_in[10];
    p.out = (float*)d_out; p.ws = (unsigned char*)d_ws;
    (void)hipMemsetAsync((char*)d_ws + WS_CTL, 0, CTL_ZERO_BYTES, stream);
    launch_fwd(p, 0, NPHASE, 0, grid, stream);
}
```

```cpp
#include <hip/hip_runtime.h>
#include <cstdio>
#include <cstdint>
#include <cmath>

constexpr int D = 1024, BATCH = 4, T = 8192, DEPTH = 2, M = BATCH * T;
constexpr int NH = 8, NKV = 2, HD = 64, AW = 512, KVW = 128, WIN = 128;
constexpr int HH = 4, HDK = 128, HW = 512, CHUNK = 64;
constexpr int NIN = 5376;
constexpr float EPS = 1e-6f;
constexpr int C_Q = 0, C_K = 512, C_V = 640, C_Z = 768, C_QH = 1280, C_FH = 1792, C_IH = 2304, C_GH = 2816, C_GA = 3328, C_GB = 4352;

constexpr size_t MiB = 1u << 20;
constexpr size_t WS_CTL = 0;
constexpr size_t WS_WIN = 2 * MiB, WS_WUA = 23 * MiB, WS_WUH = 25 * MiB, WS_WOUT = 27 * MiB;
constexpr size_t WS_COS = 31 * MiB, WS_SIN = 32 * MiB, WS_LB = 33 * MiB, WS_SSQ = 34 * MiB;
constexpr size_t WS_HD = 36 * MiB, WS_HS = 37 * MiB;
constexpr size_t WS_XB = 54 * MiB, WS_Q = 118 * MiB, WS_KV = 150 * MiB, WS_ZS = 166 * MiB, WS_QH = 198 * MiB, WS_LOGF = 230 * MiB;
constexpr size_t WS_IH = 294 * MiB, WS_GS = 326 * MiB, WS_GA = 358 * MiB, WS_GB = 422 * MiB, WS_HSS = 486 * MiB, WS_END = 502 * MiB;

typedef unsigned short bf16;

__device__ __forceinline__ unsigned f2bf(float f) { unsigned u = __builtin_bit_cast(unsigned, f); return (u + 0x7fffu + ((u >> 16) & 1u)) >> 16; }
__device__ __forceinline__ float bf2f(unsigned short h) { return __builtin_bit_cast(float, (unsigned)h << 16); }
__device__ __forceinline__ float sigm(float x) { return 1.f / (1.f + __expf(-x)); }
__device__ __forceinline__ float silu(float x) { return x * sigm(x); }
__host__ __device__ __forceinline__ int src_col(int n) {
    if (n >= C_GA) { const int t = (n - C_GA) >> 8, r = (n - C_GA) & 255; return r < 128 ? C_GA + 128 * t + r : C_GB + 128 * t + (r - 128); }
    if (n >= C_V) return n;
    const int p = n & 63;
    if (p >= 16) return n;
    return (n & ~63) + (p & 1) * 8 + (p >> 1);
}

struct Ptrs {
    const float *x; const int* pos; const float *norm_w, *w_in, *sinks, *hnw, *w_ua, *w_uh, *w_out, *lb_logits, *fnw;
    float* out; unsigned char* ws;
};

namespace pg8 {
#define PG8_LAS __attribute__((address_space(3)))
typedef unsigned short bf16_t;
typedef short bf16x8 __attribute__((ext_vector_type(8)));
typedef float f32x4 __attribute__((ext_vector_type(4)));
typedef unsigned u32x4 __attribute__((ext_vector_type(4)));
constexpr int BM = 256, BK = 64, HALF = 128, HTB = HALF * BK * 2  , STAGE_BYTES = 8 * HTB, NXCD = 8, WGM = 2;

__host__ __device__ __forceinline__ int lds_byte(int r, int c) { const int st = (r >> 4) * 2 + (c >> 5), rr = r & 15, cc = c & 31, ob = rr * 64 + cc * 2; return st * 1024 + (ob ^ (((ob >> 9) & 1) << 5)); }
__host__ __device__ __forceinline__ void stage_rc(int b, int& R, int& C) { const int st = b / 1024, sb = b % 1024, swz = sb ^ (((sb >> 9) & 1) << 5); R = (st >> 1) * 16 + swz / 64; C = (st & 1) * 32 + (swz % 64) / 2; }
__host__ __device__ __forceinline__ int perm32(int rho) { const int n = rho >> 4, i = rho & 15; return 8 * (i >> 2) + 4 * n + (i & 3); }

struct Unit { int pm, pn, seg; };
struct Gemm { const bf16_t* A; const bf16_t* Bt; int M, N, K; const bf16_t* A2; const bf16_t* Bt2; };

struct StaticOrder {
    int nM, nN, nwg, G, c, wgm;
    __host__ __device__ void init(int M, int N, int G_, int c_, int wgm_ = WGM) { nM = M / BM; nN = N / BM; nwg = nM * nN; G = G_; c = c_; wgm = wgm_; }
    __host__ __device__ bool next(int i, Unit& u) const {
        const long L = (long)i * G + c; if (L >= nwg) return false;
        int wgid = (int)L; { const int q = nwg / NXCD, r = nwg % NXCD, xcd = wgid % NXCD, off = wgid / NXCD; wgid = (xcd < r ? xcd * (q + 1) : r * (q + 1) + (xcd - r) * q) + off; }
        const int nig = wgm * nN, gid = wgid / nig, fm = gid * wgm, gsz = (nM - fm) < wgm ? (nM - fm) : wgm;
        u.pm = fm + ((wgid % nig) % gsz); u.pn = (wgid % nig) / gsz; u.seg = 0; return true;
    }
    __device__ __forceinline__ void a_ready(const Unit&) const {}
    __device__ __forceinline__ void done(const Unit&) const {}
};

struct StaticOrder2 {
    StaticOrder so;
    __host__ __device__ void init(int M, int N, int G_, int c_) { so.init(M, N, G_, c_); }
    __host__ __device__ bool next(int i, Unit& u) const { if (!so.next(i >> 1, u)) return false; u.seg = i & 1; return true; }
    __device__ __forceinline__ void a_ready(const Unit&) const {}
    __device__ __forceinline__ void done(const Unit&) const {}
};
__device__ __forceinline__ unsigned cvt_pk_bf16(float lo, float hi) { unsigned r; asm volatile("v_cvt_pk_bf16_f32 %0, %1, %2" : "=v"(r) : "v"(lo), "v"(hi)); return r; }
typedef float f32x2 __attribute__((ext_vector_type(2)));
#define PG8_GAS __attribute__((address_space(1)))
__device__ __forceinline__ float fexp(float x) { return __builtin_amdgcn_exp2f(x * 1.4426950408889634f); }
__device__ __forceinline__ float fsig(float x) { return __builtin_amdgcn_rcpf(1.f + fexp(-x)); }
__device__ __forceinline__ float flog(float x) { return __builtin_amdgcn_logf(x) * 0.6931471805599453f; }
__device__ __forceinline__ u32x4 pack8(const f32x4& a, const f32x4& b) { u32x4 w; w.x = cvt_pk_bf16(a[0], a[1]); w.y = cvt_pk_bf16(a[2], a[3]); w.z = cvt_pk_bf16(b[0], b[1]); w.w = cvt_pk_bf16(b[2], b[3]); return w; }
__device__ __forceinline__ void unpack8(const u32x4& w, f32x4& a, f32x4& b) {
    a[0] = __builtin_bit_cast(float, w.x << 16); a[1] = __builtin_bit_cast(float, w.x & 0xffff0000u); a[2] = __builtin_bit_cast(float, w.y << 16); a[3] = __builtin_bit_cast(float, w.y & 0xffff0000u);
    b[0] = __builtin_bit_cast(float, w.z << 16); b[1] = __builtin_bit_cast(float, w.z & 0xffff0000u); b[2] = __builtin_bit_cast(float, w.w << 16); b[3] = __builtin_bit_cast(float, w.w & 0xffff0000u); }
__device__ __forceinline__ float logf_gate(float x, float lb) {
    const float e = fexp(-__builtin_fabsf(x)), r = __builtin_amdgcn_rcpf(1.f + e), sneg = e * r;
    const float kin = (1.f - lb) * sneg;
    const float ser = -kin * (1.f + kin * (0.5f + kin * (0.33333334f + 0.25f * kin)));
    const float f = (x < 0.f) ? (lb + (1.f - lb) * sneg) : (1.f - kin);
    const float lg = flog(f);
    return (x >= 0.f && kin < 0.03f) ? ser : lg;
}
struct EpiInProj {
    static constexpr bool PERM = true, AFTER_DRAIN = false;
    PG8_GAS unsigned char* ws; int l; bool dry;
    __device__ __forceinline__ void init(f32x4 (&acc)[2][2][4][2], const Unit&, int, int, int, int) const {
#pragma unroll
        for (int a = 0; a < 2; ++a)
#pragma unroll
            for (int b = 0; b < 2; ++b)
#pragma unroll
                for (int m = 0; m < 4; ++m)
#pragma unroll
                    for (int n = 0; n < 2; ++n) acc[a][b][m][n] = (f32x4){0.f, 0.f, 0.f, 0.f}; }
    __device__ __forceinline__ void operator()(const f32x4 (&acc)[2][2][4][2], const Unit& u, int wr, int wc, int fr, int fq) const {
        if (dry) { asm volatile("" :: "v"(acc[0][0][0][0]), "v"(acc[0][1][1][1]), "v"(acc[1][0][2][0]), "v"(acc[1][1][3][1])); return; }
        const int row0 = u.pm * BM + wr * 64 + fr;
        float rstd[2][4];
        { f32x4 sq[2][4];
#pragma unroll
            for (int ai = 0; ai < 2; ++ai)
#pragma unroll
                for (int m = 0; m < 4; ++m) sq[ai][m] = *(const PG8_GAS f32x4*)((const PG8_GAS float*)(ws + WS_SSQ) + (size_t)(row0 + ai * HALF + m * 16) * 16 + 4 * fq);
#pragma unroll
            for (int ai = 0; ai < 2; ++ai)
#pragma unroll
                for (int m = 0; m < 4; ++m) { float t = (sq[ai][m][0] + sq[ai][m][1]) + (sq[ai][m][2] + sq[ai][m][3]); t += __shfl_xor(t, 16); t += __shfl_xor(t, 32);
                    rstd[ai][m] = __builtin_amdgcn_rsqf(t * (1.f / D) + EPS); } }
        if (u.pn * BM >= C_GA) {
            const int dcol = 128 * (u.pn - C_GA / BM) + wc * 32 + 8 * fq;
#pragma unroll
            for (int ai = 0; ai < 2; ++ai)
#pragma unroll
                for (int m = 0; m < 4; ++m) { const int row = row0 + ai * HALF + m * 16; f32x4 r0, r1, g0, g1;
#pragma unroll
                    for (int e = 0; e < 4; ++e) {
                        const float ea0 = fexp(-acc[ai][0][m][0][e] * rstd[ai][m]), eb0 = __builtin_fminf(fexp(-acc[ai][1][m][0][e] * rstd[ai][m]), 1e18f);
                        const float ea1 = fexp(-acc[ai][0][m][1][e] * rstd[ai][m]), eb1 = __builtin_fminf(fexp(-acc[ai][1][m][1][e] * rstd[ai][m]), 1e18f);
                        g0[e] = __builtin_amdgcn_rcpf(1.f + eb0); r0[e] = (1.f + eb0) * __builtin_amdgcn_rcpf(1.f + ea0);
                        g1[e] = __builtin_amdgcn_rcpf(1.f + eb1); r1[e] = (1.f + eb1) * __builtin_amdgcn_rcpf(1.f + ea1); }
                    *(PG8_GAS u32x4*)((PG8_GAS bf16_t*)(ws + WS_GA) + (size_t)row * D + dcol) = pack8(r0, r1);
                    *(PG8_GAS u32x4*)((PG8_GAS bf16_t*)(ws + WS_GB) + (size_t)row * D + dcol) = pack8(g0, g1); }
            return;
        }
#pragma unroll
        for (int bj = 0; bj < 2; ++bj) {
            const int cseg = u.pn * BM + bj * HALF;
            const int cl = wc * 32 + 8 * fq;
            int kind, ldc, dcol; size_t boff;
            float scale = 1.f;
            if (cseg < C_K)       { kind = 3; boff = WS_Q;    ldc = AW;  dcol = cseg + cl; scale = 0.125f; }
            else if (cseg < C_V)  { kind = 3; boff = WS_KV;   ldc = 256; dcol = cseg - C_K + cl; }
            else if (cseg < C_Z)  { kind = 0; boff = WS_KV;   ldc = 256; dcol = cseg - C_K + cl; }
            else if (cseg < C_QH) { kind = 1; boff = WS_ZS;   ldc = AW;  dcol = cseg - C_Z + cl; }
            else if (cseg < C_FH) { kind = 1; boff = WS_QH;   ldc = HW;  dcol = cseg - C_QH + cl; }
            else if (cseg < C_IH) { kind = 4; boff = WS_LOGF; ldc = HW;  dcol = cseg - C_FH + cl; }
            else if (cseg < C_GH) { kind = 0; boff = WS_IH;   ldc = HW;  dcol = cseg - C_IH + cl; }
            else                  { kind = 1; boff = WS_GS;   ldc = HW;  dcol = cseg - C_GH + cl; }
            if (kind == 4) {
                const f32x4 lb0 = *(const PG8_GAS f32x4*)((const PG8_GAS float*)(ws + WS_LB) + l * HW + dcol), lb1 = *(const PG8_GAS f32x4*)((const PG8_GAS float*)(ws + WS_LB) + l * HW + dcol + 4);
#pragma unroll
                for (int ai = 0; ai < 2; ++ai)
#pragma unroll
                    for (int m = 0; m < 4; ++m) { const int row = row0 + ai * HALF + m * 16; const f32x4 v0 = acc[ai][bj][m][0] * rstd[ai][m], v1 = acc[ai][bj][m][1] * rstd[ai][m]; f32x4 o0, o1;
#pragma unroll
                        for (int e = 0; e < 4; ++e) { o0[e] = logf_gate(v0[e], lb0[e]); o1[e] = logf_gate(v1[e], lb1[e]); }
                        typedef _Float16 f16x2 __attribute__((ext_vector_type(2)));
                        u32x4 hw; hw.x = __builtin_bit_cast(unsigned, (f16x2){(_Float16)o0[0], (_Float16)o0[1]}); hw.y = __builtin_bit_cast(unsigned, (f16x2){(_Float16)o0[2], (_Float16)o0[3]});
                        hw.z = __builtin_bit_cast(unsigned, (f16x2){(_Float16)o1[0], (_Float16)o1[1]}); hw.w = __builtin_bit_cast(unsigned, (f16x2){(_Float16)o1[2], (_Float16)o1[3]});
                        *(PG8_GAS u32x4*)((PG8_GAS bf16_t*)(ws + boff) + (size_t)row * ldc + dcol) = hw; }
            } else if (kind == 3) {
                const bool rot = ((wc & 1) == 0) && (fq < 2);
#pragma unroll
                for (int ai = 0; ai < 2; ++ai)
#pragma unroll
                    for (int mp = 0; mp < 2; ++mp) {
                        f32x4 cs[2], sn[2];
                        if (rot) {
#pragma unroll
                            for (int mm = 0; mm < 2; ++mm) { const int row = row0 + ai * HALF + (2 * mp + mm) * 16; cs[mm] = *(const PG8_GAS f32x4*)((const PG8_GAS float*)(ws + WS_COS) + (size_t)row * 8 + 4 * fq); sn[mm] = *(const PG8_GAS f32x4*)((const PG8_GAS float*)(ws + WS_SIN) + (size_t)row * 8 + 4 * fq); } }
                        asm volatile("" ::: "memory");
#pragma unroll
                        for (int mm = 0; mm < 2; ++mm) { const int m = 2 * mp + mm; const int row = row0 + ai * HALF + m * 16; f32x4 v0 = acc[ai][bj][m][0] * rstd[ai][m], v1 = acc[ai][bj][m][1] * rstd[ai][m];
                            if (rot) { const f32x4 c = cs[mm], s = sn[mm];
                                f32x4 r0, r1;
                                r0[0] = v0[0] * c[0] - v0[1] * s[0]; r0[1] = v0[1] * c[0] + v0[0] * s[0]; r0[2] = v0[2] * c[1] - v0[3] * s[1]; r0[3] = v0[3] * c[1] + v0[2] * s[1];
                                r1[0] = v1[0] * c[2] - v1[1] * s[2]; r1[1] = v1[1] * c[2] + v1[0] * s[2]; r1[2] = v1[2] * c[3] - v1[3] * s[3]; r1[3] = v1[3] * c[3] + v1[2] * s[3];
                                v0 = r0; v1 = r1; }
                            v0 = v0 * scale; v1 = v1 * scale;
                            *(PG8_GAS u32x4*)((PG8_GAS bf16_t*)(ws + boff) + (size_t)row * ldc + dcol) = pack8(v0, v1); }
                        asm volatile("" ::: "memory"); }
            } else {
#pragma unroll
                for (int ai = 0; ai < 2; ++ai)
#pragma unroll
                    for (int m = 0; m < 4; ++m) { const int row = row0 + ai * HALF + m * 16; f32x4 v0 = acc[ai][bj][m][0] * rstd[ai][m], v1 = acc[ai][bj][m][1] * rstd[ai][m];
                        if (kind != 0) {
#pragma unroll
                            for (int e = 0; e < 4; ++e) { v0[e] *= fsig(v0[e]); v1[e] *= fsig(v1[e]); } }
                        *(PG8_GAS u32x4*)((PG8_GAS bf16_t*)(ws + boff) + (size_t)row * ldc + dcol) = pack8(v0, v1); }
            }
        }
    }
};
struct EpiUp2 {
    static constexpr bool PERM = true, AFTER_DRAIN = false;
    PG8_GAS unsigned char* ws; bool dry;
    __device__ __forceinline__ void init(f32x4 (&acc)[2][2][4][2], const Unit& u, int, int, int, int) const {
        if (u.seg != 0) return;
#pragma unroll
        for (int a = 0; a < 2; ++a)
#pragma unroll
            for (int b = 0; b < 2; ++b)
#pragma unroll
                for (int m = 0; m < 4; ++m)
#pragma unroll
                    for (int n = 0; n < 2; ++n) acc[a][b][m][n] = (f32x4){0.f, 0.f, 0.f, 0.f}; }
    __device__ __forceinline__ void operator()(f32x4 (&acc)[2][2][4][2], const Unit& u, int wr, int wc, int fr, int fq) const {
        const int row0 = u.pm * BM + wr * 64 + fr, col0 = u.pn * BM + wc * 32 + 8 * fq;
        const size_t gbase = u.seg == 0 ? WS_GA : WS_GB;
#pragma unroll
        for (int am = 0; am < 4; ++am) { const int ai = am >> 1, mb = 2 * (am & 1);
            u32x4 gm[4][2];
#pragma unroll
            for (int m = mb; m < mb + 2; ++m)
#pragma unroll
                for (int bj = 0; bj < 2; ++bj) gm[m][bj] = *(const PG8_GAS u32x4*)((const PG8_GAS bf16_t*)(ws + gbase) + (size_t)(row0 + ai * HALF + m * 16) * D + col0 + bj * HALF);
            asm volatile("" ::: "memory");
#pragma unroll
            for (int m = mb; m < mb + 2; ++m)
#pragma unroll
                for (int bj = 0; bj < 2; ++bj) { f32x4 g0, g1; unpack8(gm[m][bj], g0, g1);
                    const f32x4 o0 = g0 * acc[ai][bj][m][0], o1 = g1 * acc[ai][bj][m][1];
                    if (u.seg == 0) { acc[ai][bj][m][0] = o0; acc[ai][bj][m][1] = o1; }
                    else if (!dry) *(PG8_GAS u32x4*)((PG8_GAS bf16_t*)(ws + WS_GA) + (size_t)(row0 + ai * HALF + m * 16) * D + col0 + bj * HALF) = pack8(o0, o1); }
            asm volatile("" ::: "memory");
        }
    }
};
struct EpiOut {
    static constexpr bool PERM = true, AFTER_DRAIN = false;
    PG8_GAS unsigned char* ws; const PG8_GAS float* xin; PG8_GAS float* out; const PG8_GAS float* fnw; PG8_LAS unsigned char* lx; bool last, dry;
    __device__ __forceinline__ void init(f32x4 (&acc)[2][2][4][2], const Unit& u, int wr, int wc, int fr, int fq) const {
        const int row0 = u.pm * BM + wr * 64 + fr, col0 = u.pn * BM + wc * 32 + 8 * fq;
        if (!last) {
#pragma unroll
            for (int ai = 0; ai < 2; ++ai)
#pragma unroll
                for (int bj = 0; bj < 2; ++bj)
#pragma unroll
                    for (int m = 0; m < 4; ++m) { const size_t off = (size_t)(row0 + ai * HALF + m * 16) * D + col0 + bj * HALF; acc[ai][bj][m][0] = *(const PG8_GAS f32x4*)(xin + off); acc[ai][bj][m][1] = *(const PG8_GAS f32x4*)(xin + off + 4); }
        } else {
#pragma unroll
            for (int ai = 0; ai < 2; ++ai)
#pragma unroll
                for (int bj = 0; bj < 2; ++bj)
#pragma unroll
                    for (int m = 0; m < 4; ++m) { const size_t off = (size_t)(row0 + ai * HALF + m * 16) * D + col0 + bj * HALF; const u32x4 wv = *(const PG8_GAS u32x4*)((const PG8_GAS bf16_t*)(ws + WS_XB) + off); unpack8(wv, acc[ai][bj][m][0], acc[ai][bj][m][1]); }
        }
    }
    __device__ __forceinline__ void operator()(const f32x4 (&acc)[2][2][4][2], const Unit& u, int wr, int wc, int fr, int fq) const {
        const int row0 = u.pm * BM + wr * 64 + fr, col0 = u.pn * BM + wc * 32 + 8 * fq;
        if (!last) {
#pragma unroll
            for (int ai = 0; ai < 2; ++ai)
#pragma unroll
                for (int m = 0; m < 4; ++m) { const int row = row0 + ai * HALF + m * 16; float ss = 0.f;
#pragma unroll
                    for (int bj = 0; bj < 2; ++bj) { const size_t off = (size_t)row * D + col0 + bj * HALF;
                        const f32x4 x0 = acc[ai][bj][m][0], x1 = acc[ai][bj][m][1];
                        if (!dry) *(PG8_GAS u32x4*)((PG8_GAS bf16_t*)(ws + WS_XB) + off) = pack8(x0, x1);
                        ss += ((x0[0] * x0[0] + x0[1] * x0[1]) + (x0[2] * x0[2] + x0[3] * x0[3])) + ((x1[0] * x1[0] + x1[1] * x1[1]) + (x1[2] * x1[2] + x1[3] * x1[3])); }
                    ss += __shfl_xor(ss, 16); ss += __shfl_xor(ss, 32);
                    if (fq == 0 && !dry) ((PG8_GAS float*)(ws + WS_SSQ))[(size_t)row * 16 + u.pn * 4 + wc] = ss; }
            return;
        }
        if (dry) { asm volatile("" :: "v"(acc[0][0][0][0]), "v"(acc[1][1][3][1])); return; }
        int tid = threadIdx.x; asm volatile("" : "+v"(tid));
        PG8_LAS float* P = (PG8_LAS float*)lx;
        PG8_LAS float* R = (PG8_LAS float*)(lx + 4096);
#pragma unroll
        for (int ai = 0; ai < 2; ++ai)
#pragma unroll
            for (int m = 0; m < 4; ++m) { float ss = 0.f;
#pragma unroll
                for (int bj = 0; bj < 2; ++bj) { const f32x4 x0 = acc[ai][bj][m][0], x1 = acc[ai][bj][m][1];
                    ss += ((x0[0] * x0[0] + x0[1] * x0[1]) + (x0[2] * x0[2] + x0[3] * x0[3])) + ((x1[0] * x1[0] + x1[1] * x1[1]) + (x1[2] * x1[2] + x1[3] * x1[3])); }
                ss += __shfl_xor(ss, 16); ss += __shfl_xor(ss, 32);
                if (fq == 0) P[(ai * HALF + wr * 64 + m * 16 + fr) * 4 + wc] = ss; }
        asm volatile("s_waitcnt lgkmcnt(0)" ::: "memory"); __builtin_amdgcn_s_barrier(); asm volatile("" ::: "memory");
        PG8_GAS unsigned* slots = (PG8_GAS unsigned*)(ws + WS_SSQ) + (size_t)u.pm * BM * 4;
        PG8_GAS unsigned* cnt = (PG8_GAS unsigned*)(ws + WS_CTL) + 32768 + 64 * u.pm;
        if (tid < BM) { const f32x4 pv = *(const PG8_LAS f32x4*)(P + tid * 4);
            __hip_atomic_store(slots + tid * 4 + u.pn, __builtin_bit_cast(unsigned, (pv[0] + pv[1]) + (pv[2] + pv[3])), __ATOMIC_RELAXED, __HIP_MEMORY_SCOPE_AGENT); }
        asm volatile("s_waitcnt vmcnt(0)" ::: "memory");
        __builtin_amdgcn_s_barrier(); asm volatile("" ::: "memory");
        if (tid == 0) __hip_atomic_fetch_add(cnt, 1u, __ATOMIC_RELAXED, __HIP_MEMORY_SCOPE_AGENT);
        if (tid < 64) { unsigned sp = 0;
            while ((unsigned)__builtin_amdgcn_readfirstlane(__hip_atomic_load(cnt, __ATOMIC_RELAXED, __HIP_MEMORY_SCOPE_AGENT)) < 4u) { __builtin_amdgcn_s_sleep(2); if (++sp > (1u << 16)) break; }
            __builtin_amdgcn_fence(__ATOMIC_ACQUIRE, "agent"); }
        asm volatile("s_waitcnt vmcnt(0) lgkmcnt(0)" ::: "memory"); __builtin_amdgcn_s_barrier(); asm volatile("" ::: "memory");
        if (tid < BM) { float tot = 0.f;
#pragma unroll
            for (int j = 0; j < 4; ++j) tot += __builtin_bit_cast(float, __hip_atomic_load(slots + tid * 4 + j, __ATOMIC_RELAXED, __HIP_MEMORY_SCOPE_AGENT));
            R[tid] = __builtin_amdgcn_rsqf(tot * (1.f / D) + EPS); }
        f32x4 gw[2][2];
#pragma unroll
        for (int bj = 0; bj < 2; ++bj) { gw[bj][0] = *(const PG8_GAS f32x4*)(fnw + col0 + bj * HALF); gw[bj][1] = *(const PG8_GAS f32x4*)(fnw + col0 + bj * HALF + 4); }
        asm volatile("s_waitcnt lgkmcnt(0)" ::: "memory"); __builtin_amdgcn_s_barrier(); asm volatile("" ::: "memory");
#pragma unroll
        for (int ai = 0; ai < 2; ++ai)
#pragma unroll
            for (int m = 0; m < 4; ++m) { const int rl = ai * HALF + wr * 64 + m * 16 + fr; const float rs = R[rl];
#pragma unroll
                for (int bj = 0; bj < 2; ++bj) { const size_t off = (size_t)(u.pm * BM + rl) * D + col0 + bj * HALF;
                    *(PG8_GAS f32x4*)(out + off) = acc[ai][bj][m][0] * rs * gw[bj][0]; *(PG8_GAS f32x4*)(out + off + 4) = acc[ai][bj][m][1] * rs * gw[bj][1]; } }
        asm volatile("s_waitcnt lgkmcnt(0)" ::: "memory"); __builtin_amdgcn_s_barrier(); asm volatile("" ::: "memory");
    }
};

template <class Epi, class Sched, bool ALIGN_EPI = false, bool SP2 = false>
__device__ __forceinline__ void gemm_phase(PG8_LAS unsigned char* lds, const Gemm g, const Sched& S, const Epi& E) {
    int tid_ = threadIdx.x; asm volatile("" : "+v"(tid_));
    const int tid = tid_, wid = __builtin_amdgcn_readfirstlane(tid >> 6), lane = tid & 63, wr = wid >> 2, wc = wid & 3, fr = lane & 15, fq = lane >> 4;
    const int K = g.K, nt = K / BK;
    unsigned voffA[2], voffB[2];
#pragma unroll
    for (int i = 0; i < 2; ++i) { int R, C; stage_rc(tid * 16 + i * 8192, R, C); const int Rb = Epi::PERM ? ((R & ~31) + perm32(R & 31)) : R;
        voffA[i] = (unsigned)(R * K + C) * 2u; voffB[i] = (unsigned)(Rb * K + C) * 2u; }
    const size_t kstep = (size_t)(BK * 2);
    const size_t hstep = (size_t)HALF * K * 2;
    const size_t tstep = 2 * hstep;
    const unsigned ldsw = (unsigned)wid * 1024u;
    const int aoff = lds_byte(wr * 64 + fr, fq * 8), boff = lds_byte(wc * 32 + fr, fq * 8);
#define PG8_SA(b, h) (((b) * 2 + (h)) * HTB)
#define PG8_SB(b, h) ((4 + (b) * 2 + (h)) * HTB)
#define PG8_STAGE(bufoff, gbase, voff) do { _Pragma("unroll") for (int _i = 0; _i < 2; ++_i) \
        __builtin_amdgcn_global_load_lds((const unsigned*)((const char*)(gbase) + (voff)[_i]), (PG8_LAS unsigned*)(lds + (bufoff) + ldsw + _i * 8192), 16, 0, 0); } while (0)
#define PG8_LDA(dst, b, h) do { _Pragma("unroll") for (int m = 0; m < 4; ++m) _Pragma("unroll") for (int k = 0; k < 2; ++k) dst[m][k] = *(const PG8_LAS bf16x8*)(lds + PG8_SA(b, h) + aoff + m * 2048 + k * 1024); } while (0)
#define PG8_LDB(dst, b, h) do { _Pragma("unroll") for (int n = 0; n < 2; ++n) _Pragma("unroll") for (int k = 0; k < 2; ++k) dst[n][k] = *(const PG8_LAS bf16x8*)(lds + PG8_SB(b, h) + boff + n * 2048 + k * 1024); } while (0)
#define PG8_MMA(ai, bj, At, Bt) do { __builtin_amdgcn_s_setprio(1); _Pragma("unroll") for (int m = 0; m < 4; ++m) _Pragma("unroll") for (int n = 0; n < 2; ++n) _Pragma("unroll") for (int k = 0; k < 2; ++k) \
        acc[ai][bj][m][n] = __builtin_amdgcn_mfma_f32_16x16x32_bf16(Bt[n][k], At[m][k], acc[ai][bj][m][n], 0, 0, 0); __builtin_amdgcn_s_setprio(0); } while (0)
#define PG8_WAIT_V(n) asm volatile("s_waitcnt vmcnt(" #n ")" ::: "memory")
#define PG8_WAIT_L(n) asm volatile("s_waitcnt lgkmcnt(" #n ")" ::: "memory")
#define PG8_BAR __builtin_amdgcn_s_barrier()
#define PG8_SCHED __builtin_amdgcn_sched_barrier(0)
    Unit cur, nxt; int ui = 0;
    if (!S.next(0, cur)) return;
    f32x4 acc[2][2][4][2];
    E.init(acc, cur, wr, wc, fr, fq);
    bf16x8 At[4][2], B0[2][2], B1[2][2];
    const char* cA = (const char*)(cur.seg ? g.A2 : g.A) + (size_t)cur.pm * tstep; const char* cB = (const char*)(cur.seg ? g.Bt2 : g.Bt) + (size_t)cur.pn * tstep;
    S.a_ready(cur);
    if constexpr (SP2) {
        PG8_STAGE(PG8_SB(0, 0), cB, voffB); PG8_STAGE(PG8_SB(0, 1), cB + hstep, voffB); PG8_STAGE(PG8_SA(0, 0), cA, voffA); PG8_STAGE(PG8_SA(0, 1), cA + hstep, voffA);
        if (wr == 1) PG8_BAR;
        PG8_WAIT_V(2); PG8_BAR;
        PG8_STAGE(PG8_SB(1, 0), cB + kstep, voffB); PG8_STAGE(PG8_SA(1, 0), cA + kstep, voffA); PG8_STAGE(PG8_SB(1, 1), cB + hstep + kstep, voffB);
        PG8_WAIT_V(6); PG8_BAR;
    } else {
        PG8_STAGE(PG8_SB(0, 0), cB, voffB); PG8_STAGE(PG8_SA(0, 0), cA, voffA); PG8_STAGE(PG8_SB(0, 1), cB + hstep, voffB); PG8_STAGE(PG8_SA(0, 1), cA + hstep, voffA);
        if (wr == 1) PG8_BAR;
        PG8_WAIT_V(4); PG8_BAR;
        PG8_STAGE(PG8_SB(1, 0), cB + kstep, voffB); PG8_STAGE(PG8_SA(1, 0), cA + kstep, voffA); PG8_STAGE(PG8_SB(1, 1), cB + hstep + kstep, voffB);
        PG8_WAIT_V(6); PG8_BAR;
    }
    for (;;) {
        const bool has_next = S.next(ui + 1, nxt);
        const char* nA = has_next ? (const char*)(nxt.seg ? g.A2 : g.A) + (size_t)nxt.pm * tstep : cA; const char* nB = has_next ? (const char*)(nxt.seg ? g.Bt2 : g.Bt) + (size_t)nxt.pn * tstep : cB;
        for (int t = 0; t < nt; t += 2) {
            const bool last = (t == nt - 2);
            const char* a1 = cA + (size_t)(t + 1) * kstep;
            const char* a2 = last ? nA : cA + (size_t)(t + 2) * kstep; const char* b2 = last ? nB : cB + (size_t)(t + 2) * kstep;
            const char* a3 = a2 + kstep; const char* b3 = b2 + kstep;
            if (last && has_next) S.a_ready(nxt);
            if constexpr (SP2) {
            PG8_LDB(B0, 0, 0); PG8_LDB(B1, 0, 1); PG8_SCHED; PG8_LDA(At, 0, 0); PG8_STAGE(PG8_SA(1, 1), a1 + hstep, voffA);
            PG8_WAIT_V(8); PG8_WAIT_L(0); PG8_BAR; PG8_MMA(0, 0, At, B0); PG8_MMA(0, 1, At, B1); PG8_BAR; PG8_SCHED;
            PG8_LDA(At, 0, 1); PG8_STAGE(PG8_SB(0, 0), b2, voffB); PG8_STAGE(PG8_SB(0, 1), b2 + hstep, voffB); PG8_STAGE(PG8_SA(0, 0), a2, voffA);
            PG8_WAIT_V(8); PG8_WAIT_L(0); PG8_BAR; PG8_MMA(1, 0, At, B0); PG8_MMA(1, 1, At, B1); PG8_BAR; PG8_SCHED;
            PG8_LDB(B0, 1, 0); PG8_LDB(B1, 1, 1); PG8_SCHED; PG8_LDA(At, 1, 0); PG8_STAGE(PG8_SA(0, 1), a2 + hstep, voffA);
            PG8_WAIT_V(8); PG8_WAIT_L(0); PG8_BAR; PG8_MMA(0, 0, At, B0); PG8_MMA(0, 1, At, B1); PG8_BAR; PG8_SCHED;
            PG8_LDA(At, 1, 1); PG8_STAGE(PG8_SB(1, 0), b3, voffB); PG8_STAGE(PG8_SB(1, 1), b3 + hstep, voffB); PG8_STAGE(PG8_SA(1, 0), a3, voffA);
            PG8_WAIT_V(8); PG8_WAIT_L(0); PG8_BAR; PG8_MMA(1, 0, At, B0); PG8_MMA(1, 1, At, B1); PG8_BAR; PG8_SCHED;
            } else {
            PG8_LDB(B0, 0, 0); PG8_SCHED; PG8_LDA(At, 0, 0); PG8_STAGE(PG8_SA(1, 1), a1 + hstep, voffA);
            PG8_WAIT_L(8); PG8_BAR; PG8_WAIT_L(0); PG8_MMA(0, 0, At, B0); PG8_BAR; PG8_SCHED;
            PG8_LDB(B1, 0, 1); PG8_STAGE(PG8_SB(0, 0), b2, voffB);
            PG8_BAR; PG8_WAIT_L(0); PG8_MMA(0, 1, At, B1); PG8_BAR;
            PG8_LDA(At, 0, 1); PG8_STAGE(PG8_SA(0, 0), a2, voffA);
            PG8_BAR; PG8_WAIT_L(0); PG8_MMA(1, 0, At, B0); PG8_BAR; PG8_SCHED;
            PG8_STAGE(PG8_SB(0, 1), b2 + hstep, voffB);
            PG8_WAIT_V(6); PG8_BAR; PG8_MMA(1, 1, At, B1); PG8_BAR;
            PG8_LDB(B0, 1, 0); PG8_SCHED; PG8_LDA(At, 1, 0); PG8_STAGE(PG8_SA(0, 1), a2 + hstep, voffA);
            PG8_WAIT_L(8); PG8_BAR; PG8_WAIT_L(0); PG8_MMA(0, 0, At, B0); PG8_BAR; PG8_SCHED;
            PG8_LDB(B1, 1, 1); PG8_STAGE(PG8_SB(1, 0), b3, voffB);
            PG8_BAR; PG8_WAIT_L(0); PG8_MMA(0, 1, At, B1); PG8_BAR;
            PG8_LDA(At, 1, 1); PG8_STAGE(PG8_SA(1, 0), a3, voffA);
            PG8_BAR; PG8_WAIT_L(0); PG8_MMA(1, 0, At, B0); PG8_BAR; PG8_SCHED;
            PG8_STAGE(PG8_SB(1, 1), b3 + hstep, voffB);
            PG8_WAIT_V(6); PG8_BAR; PG8_MMA(1, 1, At, B1); PG8_BAR;
            }
        }
        if constexpr (ALIGN_EPI) { if (wr == 0) PG8_BAR; }
        if constexpr (!Epi::AFTER_DRAIN) { E(acc, cur, wr, wc, fr, fq); S.done(cur); }
        if (!has_next) break;
        E.init(acc, nxt, wr, wc, fr, fq);
        cur = nxt; cA = nA; cB = nB; ++ui;
        if constexpr (ALIGN_EPI) { if (wr == 1) PG8_BAR; }
    }
    PG8_WAIT_V(0);
    if constexpr (!ALIGN_EPI) { if (wr == 0) PG8_BAR; }
    PG8_BAR;
    if constexpr (Epi::AFTER_DRAIN) { E.fused(acc, cur, wr, wc, fr, fq, lds, wid, lane); S.done(cur); }
#undef PG8_SA
#undef PG8_SB
#undef PG8_STAGE
#undef PG8_LDA
#undef PG8_LDB
#undef PG8_MMA
#undef PG8_WAIT_V
#undef PG8_WAIT_L
#undef PG8_BAR
#undef PG8_SCHED
}
}
#define GAS __attribute__((address_space(1)))
#define LAS __attribute__((address_space(3)))
typedef unsigned v4u __attribute__((ext_vector_type(4)));
typedef float f32x4 __attribute__((ext_vector_type(4)));
typedef short bf16x8 __attribute__((ext_vector_type(8)));
typedef GAS unsigned gu32;
typedef GAS unsigned long long gu64;
#define RLX_AGENT __ATOMIC_RELAXED, __HIP_MEMORY_SCOPE_AGENT
#define LDS_WAIT() asm volatile("s_waitcnt lgkmcnt(0)" ::: "memory")
#define VM_WAIT() asm volatile("s_waitcnt vmcnt(0)" ::: "memory")
__device__ __forceinline__ unsigned long long rt() { return __builtin_amdgcn_s_memrealtime(); }
__device__ __forceinline__ unsigned pk2(float lo, float hi) { return f2bf(lo) | (f2bf(hi) << 16); }

#define XB_TMO      128
#define XB_XCNT(j)  (256  + 64 * (j))
#define XB_XSUB(j)  (1280 + 64 * (j))
#define XB_XGEN(j)  (2304 + 64 * (j))
#define XB_TOP      3328
#define XB_TOPGEN   3392
#define XCD_BAR_WORDS 3456
#define XB_SPIN_CAP (1u << 18)

__device__ __forceinline__ unsigned xb_ld(unsigned* p)              { return __hip_atomic_load(p, __ATOMIC_RELAXED, __HIP_MEMORY_SCOPE_AGENT); }
__device__ __forceinline__ unsigned xb_add(unsigned* p, unsigned v) { return __hip_atomic_fetch_add(p, v, __ATOMIC_RELAXED, __HIP_MEMORY_SCOPE_AGENT); }
__device__ __forceinline__ unsigned xb_xcc_id() { return (unsigned)__builtin_amdgcn_s_getreg((3 << 11) | 20) & 0xFu; }
#define XB_SPIN(cond, bar) do { unsigned _sp = 0; while (cond) { __builtin_amdgcn_s_sleep(1); \
    if ((++_sp & 255u) == 0u) { if (xb_ld(&(bar)[XB_TMO])) break; if (_sp > XB_SPIN_CAP) { atomicAdd(&(bar)[XB_TMO], 1u); break; } } } } while (0)

struct XcdBarrier {
    unsigned* bar; unsigned x;
    volatile LAS unsigned* st;
};

__device__ __forceinline__ XcdBarrier xcd_barrier_post(unsigned* bar, volatile LAS unsigned* st) {
    XcdBarrier b; b.bar = bar; b.x = xb_xcc_id(); b.st = st;
    if (threadIdx.x == 0) (void)xb_add(&bar[XB_XCNT(b.x)], 1u);
    return b;
}
__device__ __forceinline__ void xcd_barrier_complete(unsigned* bar, unsigned x, unsigned& nloc, unsigned& nx) {
    const unsigned G = gridDim.x * gridDim.y * gridDim.z;
    unsigned sum, cnt, mine, sp = 0u;
    for (;;) {
        sum = 0u; cnt = 0u; mine = 0u;
#pragma unroll
        for (unsigned j = 0; j < 16; ++j) { const unsigned c = xb_ld(&bar[XB_XCNT(j)]); sum += c; cnt += (c > 0u) ? 1u : 0u; mine = (j == x) ? c : mine; }
        if (sum == G) break;
        __builtin_amdgcn_s_sleep(1);
        if ((++sp & 255u) == 0u) { if (xb_ld(&bar[XB_TMO])) break; if (sp > XB_SPIN_CAP) { atomicAdd(&bar[XB_TMO], 1u); break; } }
    }
    nloc = mine > 0u ? mine : 1u; nx = cnt > 0u ? cnt : 1u;
}

__device__ __forceinline__ void xcd_barrier(const XcdBarrier& b) {
    asm volatile("s_waitcnt vmcnt(0)" ::: "memory");
    __syncthreads();
    if (threadIdx.x == 0) {
        unsigned* bar = b.bar;
        __builtin_amdgcn_s_waitcnt(0);
        unsigned nloc = b.st[0], nx = b.st[1];
        if (nloc == 0u) { xcd_barrier_complete(bar, b.x, nloc, nx); b.st[0] = nloc; b.st[1] = nx; }
        const unsigned old = xb_add(&bar[XB_XSUB(b.x)], 1u);
        const unsigned gen = old / nloc;
        if (old + 1u == (gen + 1u) * nloc) {
            __builtin_amdgcn_fence(__ATOMIC_RELEASE, "agent");
            asm volatile("s_waitcnt vmcnt(0)" ::: "memory");
            const unsigned og = xb_add(&bar[XB_TOP], 1u);
            const unsigned tg = og / nx;
            if (og + 1u == (tg + 1u) * nx) xb_add(&bar[XB_TOPGEN], 1u);
            else XB_SPIN(xb_ld(&bar[XB_TOPGEN]) == tg, bar);
            __builtin_amdgcn_fence(__ATOMIC_ACQUIRE, "agent");
            xb_add(&bar[XB_XGEN(b.x)], 1u);
            asm volatile("s_waitcnt vmcnt(0)" ::: "memory");
        } else {
            XB_SPIN(xb_ld(&bar[XB_XGEN(b.x)]) == gen, bar);
            __builtin_amdgcn_fence(__ATOMIC_ACQUIRE, "agent");
            asm volatile("s_waitcnt vmcnt(0)" ::: "memory");
        }
    }
    __syncthreads();
}

typedef float f32x16 __attribute__((ext_vector_type(16)));
typedef short s16x4 __attribute__((ext_vector_type(4)));
typedef unsigned u32x2a __attribute__((ext_vector_type(2)));
typedef float f32x2_t __attribute__((ext_vector_type(2))); typedef __bf16 bf16x2_t __attribute__((ext_vector_type(2)));
__device__ __forceinline__ unsigned cvtpk(float lo, float hi) { f32x2_t v = {lo, hi}; bf16x2_t b = __builtin_convertvector(v, bf16x2_t); return __builtin_bit_cast(unsigned, b); }
__device__ __forceinline__ int crow(int reg, int h) { return (reg & 3) + 8 * (reg >> 2) + 4 * h; }
__device__ __forceinline__ s16x4 vtr(LAS unsigned char* p) { return __builtin_bit_cast(s16x4, __builtin_amdgcn_ds_read_tr16_b64_v4i16((LAS s16x4*)p)); }
#define LDS_BARRIER() do { asm volatile("s_waitcnt lgkmcnt(0)" ::: "memory"); __builtin_amdgcn_s_barrier(); asm volatile("" ::: "memory"); } while (0)
constexpr int ATT_RS = 144;
constexpr float LOG2E = 1.4426950408889634f;
__device__ __forceinline__ void attn_unit(const Ptrs& p, int l, LAS unsigned char* L, int unit, int tid, int wave, int lane, bool dry) {
    const int b = unit >> 7, kvh = (unit >> 6) & 1, qblk = unit & 63, tok0 = qblk * 128;
    const size_t mrow0 = (size_t)b * T + tok0;
    const GAS bf16* KV = (const GAS bf16*)(p.ws + WS_KV); const GAS bf16* Q = (const GAS bf16*)(p.ws + WS_Q); GAS bf16* ZS = (GAS bf16*)(p.ws + WS_ZS);
    LAS unsigned char* Ks = L; LAS unsigned char* Vs = L + 256 * ATT_RS;
    const int r = lane & 31, h = lane >> 5, g = wave >> 1, qh = wave & 1, head = kvh * 4 + g;
    bf16x8 qfa[2][4]; u32x2a zg[2][2][4];
#pragma unroll
    for (int st = 0; st < 2; ++st) { const size_t mq = mrow0 + qh * 64 + st * 32 + r;
#pragma unroll
        for (int s = 0; s < 4; ++s) qfa[st][s] = *(const GAS bf16x8*)(Q + mq * AW + head * 64 + 16 * s + 8 * h);
#pragma unroll
        for (int dt = 0; dt < 2; ++dt)
#pragma unroll
            for (int gq = 0; gq < 4; ++gq) zg[st][dt][gq] = *(const GAS u32x2a*)(ZS + mq * AW + head * 64 + 32 * dt + 8 * gq + 4 * h); }
#pragma unroll
    for (int i = 0; i < 4; ++i) { const int c = tid + 512 * i, row = c >> 3, ch = c & 7, tok = tok0 - 128 + row;
        v4u kv = {0u, 0u, 0u, 0u}, vv = {0u, 0u, 0u, 0u};
        if (tok >= 0) { const GAS bf16* src = KV + ((size_t)b * T + tok) * 256 + kvh * 64 + ch * 8; kv = *(const GAS v4u*)src; vv = *(const GAS v4u*)(src + 128); }
        *(LAS v4u*)(Ks + row * ATT_RS + ch * 16) = kv; *(LAS v4u*)(Vs + row * ATT_RS + ch * 16) = vv; }
    LDS_BARRIER();
    const float sinkl = p.sinks[l * NH + head] * LOG2E;
#pragma unroll
    for (int st = 0; st < 2; ++st) {
        const int q0 = qh * 64 + st * 32, kt0 = q0 >> 5;
        const size_t mq = mrow0 + q0 + r;
        bf16x8 qf[4];
#pragma unroll
        for (int s = 0; s < 4; ++s) qf[s] = qfa[st][s];
        f32x16 S[5];
        {
            bf16x8 kf[2][4];
#pragma unroll
            for (int s = 0; s < 4; ++s) kf[0][s] = *(const LAS bf16x8*)(Ks + (32 * kt0 + r) * ATT_RS + (16 * s + 8 * h) * 2);
#pragma unroll
            for (int j = 0; j < 5; ++j) {
                if (j < 4) {
#pragma unroll
                    for (int s = 0; s < 4; ++s) kf[(j + 1) & 1][s] = *(const LAS bf16x8*)(Ks + (32 * (kt0 + j + 1) + r) * ATT_RS + (16 * s + 8 * h) * 2); }
                __builtin_amdgcn_sched_barrier(0);
                f32x16 a = {};
#pragma unroll
                for (int s = 0; s < 4; ++s) a = __builtin_amdgcn_mfma_f32_32x32x16_bf16(kf[j & 1][s], qf[s], a, 0, 0, 0);
                S[j] = a;
                __builtin_amdgcn_sched_barrier(0);
            }
        }
        float mx = sinkl;
#pragma unroll
        for (int j = 0; j < 5; ++j)
#pragma unroll
            for (int e = 0; e < 16; ++e) { const int cr = crow(e, h); bool valid = true;
                if (j == 0) valid = (cr - r >= 1);
                if (j == 4) valid = (cr - r <= 0);
                if (qblk == 0) valid = valid && (q0 + 32 * j + cr >= 128);
                const float t = valid ? S[j][e] * LOG2E : -INFINITY; S[j][e] = t; mx = fmaxf(mx, t); }
        mx = fmaxf(mx, __shfl_xor(mx, 32));
        float sum = 0.f;
#pragma unroll
        for (int j = 0; j < 5; ++j)
#pragma unroll
            for (int e = 0; e < 16; ++e) { const float pv = __builtin_amdgcn_exp2f(S[j][e] - mx); S[j][e] = pv; sum += pv; }
        sum += __shfl_xor(sum, 32); sum += __builtin_amdgcn_exp2f(sinkl - mx);
        f32x16 O[2]; O[0] = f32x16{}; O[1] = f32x16{};
        const int i16 = lane & 15, gg = (lane >> 4) & 1;
        {
            s16x4 vlo[2][2], vhi[2][2];
            LAS unsigned char* vp0 = Vs + (32 * kt0 + 4 * h + (i16 >> 2)) * ATT_RS + (16 * gg + 4 * (i16 & 3)) * 2;
#pragma unroll
            for (int dt = 0; dt < 2; ++dt) { vlo[0][dt] = vtr(vp0 + 64 * dt); vhi[0][dt] = vtr(vp0 + 64 * dt + 8 * ATT_RS); }
#pragma unroll
            for (int st2 = 0; st2 < 10; ++st2) { const int j = st2 >> 1, s2 = st2 & 1;
                if (st2 < 9) { LAS unsigned char* vp = vp0 + (16 * (st2 + 1)) * ATT_RS;
#pragma unroll
                    for (int dt = 0; dt < 2; ++dt) { vlo[(st2 + 1) & 1][dt] = vtr(vp + 64 * dt); vhi[(st2 + 1) & 1][dt] = vtr(vp + 64 * dt + 8 * ATT_RS); } }
                __builtin_amdgcn_sched_barrier(0);
                v4u pw; pw.x = cvtpk(S[j][8 * s2 + 0], S[j][8 * s2 + 1]); pw.y = cvtpk(S[j][8 * s2 + 2], S[j][8 * s2 + 3]); pw.z = cvtpk(S[j][8 * s2 + 4], S[j][8 * s2 + 5]); pw.w = cvtpk(S[j][8 * s2 + 6], S[j][8 * s2 + 7]);
                const bf16x8 pb = __builtin_bit_cast(bf16x8, pw);
#pragma unroll
                for (int dt = 0; dt < 2; ++dt) { const s16x4 lo = vlo[st2 & 1][dt], hi = vhi[st2 & 1][dt];
                    const bf16x8 af = {lo[0], lo[1], lo[2], lo[3], hi[0], hi[1], hi[2], hi[3]};
                    O[dt] = __builtin_amdgcn_mfma_f32_32x32x16_bf16(af, pb, O[dt], 0, 0, 0); }
                __builtin_amdgcn_sched_barrier(0);
            }
        }
        const float inv = 1.f / sum;
#pragma unroll
        for (int dt = 0; dt < 2; ++dt)
#pragma unroll
            for (int gq = 0; gq < 4; ++gq) { GAS bf16* zp = ZS + mq * AW + head * 64 + 32 * dt + 8 * gq + 4 * h;
                const u32x2a z = zg[st][dt][gq];
                const float z0 = __builtin_bit_cast(float, z.x << 16), z1 = __builtin_bit_cast(float, z.x & 0xffff0000u), z2 = __builtin_bit_cast(float, z.y << 16), z3 = __builtin_bit_cast(float, z.y & 0xffff0000u);
                u32x2a o; o.x = cvtpk(O[dt][4 * gq + 0] * inv * z0, O[dt][4 * gq + 1] * inv * z1); o.y = cvtpk(O[dt][4 * gq + 2] * inv * z2, O[dt][4 * gq + 3] * inv * z3);
                if (!dry) *(GAS u32x2a*)zp = o; }
        __builtin_amdgcn_sched_barrier(0);
    }
    LDS_BARRIER();
}
__device__ __forceinline__ void attn_phase(const Ptrs& p, int l, LAS unsigned char* L, int vcu, int G, int tid, int wave, int lane, bool dry) {
    constexpr int NU = BATCH * NKV * (T / 128);
    const int upc = (NU + G - 1) / G;
#pragma unroll 1
    for (int i = 0; i < upc; ++i) { const int unit = vcu * upc + i; if (unit < NU) attn_unit(p, l, L, unit, tid, wave, lane, dry); }
}

typedef float f32x2v __attribute__((ext_vector_type(2))); typedef unsigned u32x2v __attribute__((ext_vector_type(2)));
__device__ __forceinline__ float bflo(unsigned w) { return __builtin_bit_cast(float, w << 16); }
__device__ __forceinline__ float bfhi(unsigned w) { return __builtin_bit_cast(float, w & 0xffff0000u); }
constexpr int H_RS = 272, H_RT = 144;
constexpr int HO_QA = 0, HO_KD = HO_QA + 64 * H_RS, HO_KBT = HO_KD + 64 * H_RS, HO_VT = HO_KBT + 128 * H_RT, HO_E = HO_VT + 128 * H_RT, HSET = HO_E + 2048, HO_RED = 2 * HSET, HO_END = HO_RED + 2048;
#define row_ror(x, n) __builtin_bit_cast(float, __builtin_amdgcn_update_dpp(0, __builtin_bit_cast(int, (float)(x)), 0x120 + (n), 0xf, 0xf, false))
template <bool FULL>
__device__ __forceinline__ void hgrn_unit(const Ptrs& p, int l, LAS unsigned char* L, int unit, int tid, int wave, int lane, bool dry) {
    const int seq = unit >> 4, sc = unit & 15, b = seq >> 2, h = seq & 3, cb = h * 128;
    const size_t m0 = (size_t)b * T + sc * 512;
    const GAS unsigned short* LOGF = (const GAS unsigned short*)(p.ws + WS_LOGF);
    const GAS bf16* QH = (const GAS bf16*)(p.ws + WS_QH); const GAS bf16* IH = (const GAS bf16*)(p.ws + WS_IH); GAS bf16* GS = (GAS bf16*)(p.ws + WS_GS);
    GAS float* HS = (GAS float*)(p.ws + WS_HS); GAS float* HD = (GAS float*)(p.ws + WS_HD);
    if (wave < 4) {
        const int d0 = 2 * (tid & 63), isb = tid >> 6;
        unsigned lfX[16], vX[16], qX[16], lfY[16], vY[16], qY[16];
        float gtot0 = 0.f, gtot1 = 0.f;
#define HG_LOAD(cc, LF, VV, QQ) do { const size_t mc_ = m0 + (cc) * 64; \
            _Pragma("unroll") for (int e = 0; e < 16; ++e) { const size_t off = (mc_ + 16 * isb + e) * HW + cb + d0; \
                LF[e] = *(const GAS unsigned*)(LOGF + off); VV[e] = *(const GAS unsigned*)(IH + off); QQ[e] = FULL ? *(const GAS unsigned*)(QH + off) : 0u; } } while (0)
#define HG_BUILD(sb, LF, VV, QQ) do { float cs0[16], cs1[16], kin0[16], kin1[16]; float run0 = 0.f, run1 = 0.f; \
            _Pragma("unroll") for (int e = 0; e < 16; ++e) { typedef _Float16 f16x2_ __attribute__((ext_vector_type(2))); const f16x2_ hv = __builtin_bit_cast(f16x2_, LF[e]); \
                const float l0 = (float)hv[0], l1 = (float)hv[1]; run0 += l0; run1 += l1; cs0[e] = run0; cs1[e] = run1; kin0[e] = 1.f - pg8::fexp(l0); kin1[e] = 1.f - pg8::fexp(l1); } \
            unsigned kb0[8], kb1[8], vt0[8], vt1[8]; \
            _Pragma("unroll") for (int e = 0; e < 16; ++e) { const int t = 16 * isb + e; \
                const unsigned kbp = cvtpk(kin0[e] * pg8::fexp(run0 - cs0[e]), kin1[e] * pg8::fexp(run1 - cs1[e])); \
                if (e & 1) { kb0[e >> 1] |= kbp << 16; kb1[e >> 1] |= kbp & 0xffff0000u; vt0[e >> 1] |= VV[e] << 16; vt1[e >> 1] |= VV[e] & 0xffff0000u; } \
                else { kb0[e >> 1] = kbp & 0xffffu; kb1[e >> 1] = kbp >> 16; vt0[e >> 1] = VV[e] & 0xffffu; vt1[e >> 1] = VV[e] >> 16; } \
                if (FULL) { const float q0 = bflo(QQ[e]), q1 = bfhi(QQ[e]); \
                    *(LAS unsigned*)(L + (sb) + HO_QA + t * H_RS + d0 * 2) = cvtpk(q0 * pg8::fexp(cs0[e]), q1 * pg8::fexp(cs1[e])); \
                    *(LAS unsigned*)(L + (sb) + HO_KD + t * H_RS + d0 * 2) = cvtpk(kin0[e] * pg8::fexp(fminf(-cs0[e], 80.f)), kin1[e] * pg8::fexp(fminf(-cs1[e], 80.f))); } } \
            *(LAS v4u*)(L + (sb) + HO_KBT + d0 * H_RT + 32 * isb) = (v4u){kb0[0], kb0[1], kb0[2], kb0[3]}; *(LAS v4u*)(L + (sb) + HO_KBT + d0 * H_RT + 32 * isb + 16) = (v4u){kb0[4], kb0[5], kb0[6], kb0[7]}; \
            *(LAS v4u*)(L + (sb) + HO_KBT + (d0 + 1) * H_RT + 32 * isb) = (v4u){kb1[0], kb1[1], kb1[2], kb1[3]}; *(LAS v4u*)(L + (sb) + HO_KBT + (d0 + 1) * H_RT + 32 * isb + 16) = (v4u){kb1[4], kb1[5], kb1[6], kb1[7]}; \
            *(LAS v4u*)(L + (sb) + HO_VT + d0 * H_RT + 32 * isb) = (v4u){vt0[0], vt0[1], vt0[2], vt0[3]}; *(LAS v4u*)(L + (sb) + HO_VT + d0 * H_RT + 32 * isb + 16) = (v4u){vt0[4], vt0[5], vt0[6], vt0[7]}; \
            *(LAS v4u*)(L + (sb) + HO_VT + (d0 + 1) * H_RT + 32 * isb) = (v4u){vt1[0], vt1[1], vt1[2], vt1[3]}; *(LAS v4u*)(L + (sb) + HO_VT + (d0 + 1) * H_RT + 32 * isb + 16) = (v4u){vt1[4], vt1[5], vt1[6], vt1[7]}; \
            *(LAS f32x2v*)(L + (sb) + HO_E + (isb * 128 + d0) * 4) = (f32x2v){pg8::fexp(run0), pg8::fexp(run1)}; gtot0 += run0; gtot1 += run1; } while (0)
        HG_LOAD(0, lfX, vX, qX);
        HG_LOAD(1, lfY, vY, qY);
        HG_BUILD(0, lfX, vX, qX);
        HG_LOAD(2, lfX, vX, qX);
        LDS_BARRIER();
#pragma unroll 1
        for (int c = 0; c < 8; c += 2) {
            HG_BUILD(HSET, lfY, vY, qY);
            if (c + 3 < 8) HG_LOAD(c + 3, lfY, vY, qY);
            if (FULL) LDS_BARRIER();
            LDS_BARRIER();
            if (c + 2 < 8) { HG_BUILD(0, lfX, vX, qX); if (c + 4 < 8) HG_LOAD(c + 4, lfX, vX, qX); }
            if (FULL) LDS_BARRIER();
            LDS_BARRIER();
        }
#undef HG_LOAD
#undef HG_BUILD
        if (!FULL) {
            *(LAS f32x2v*)(L + HO_RED + (isb * 128 + d0) * 4) = (f32x2v){gtot0, gtot1};
            LDS_BARRIER();
            if (isb == 0) { f32x2v t4 = *(const LAS f32x2v*)(L + HO_RED + d0 * 4);
#pragma unroll
                for (int k = 1; k < 4; ++k) t4 += *(const LAS f32x2v*)(L + HO_RED + (k * 128 + d0) * 4);
                *(GAS f32x2v*)(HD + unit * 128 + d0) = (f32x2v){pg8::fexp(t4.x), pg8::fexp(t4.y)}; }
            LDS_BARRIER();
        }
    } else {
        const int cw = wave - 4, fr = lane & 15, g = lane >> 4;
        __builtin_amdgcn_s_setprio(2);
        f32x4 S[2][8];
#pragma unroll
        for (int s2 = 0; s2 < 2; ++s2)
#pragma unroll
            for (int kt = 0; kt < 8; ++kt) S[s2][kt] = (f32x4){0.f, 0.f, 0.f, 0.f};
        if (FULL && sc > 0) { const GAS float* HSS = (const GAS float*)(p.ws + WS_HSS);
#pragma unroll
            for (int s2 = 0; s2 < 2; ++s2)
#pragma unroll
                for (int kt = 0; kt < 8; ++kt)
#pragma unroll
                    for (int e = 0; e < 4; ++e) S[s2][kt][e] = HSS[((size_t)(unit * 8 + 2 * cw + s2) * 32 + kt * 4 + e) * 64 + lane]; }
        float nw[2]; unsigned short gsc[2][4][4];
#pragma unroll
        for (int s2 = 0; s2 < 2; ++s2) nw[s2] = FULL ? p.hnw[l * HDK + 16 * (2 * cw + s2) + fr] : 0.f;
#define HG_LOADG(cc) do { const size_t mc_ = m0 + (cc) * 64; \
            if (FULL) { _Pragma("unroll") for (int s2 = 0; s2 < 2; ++s2) _Pragma("unroll") for (int i = 0; i < 4; ++i) _Pragma("unroll") for (int e = 0; e < 4; ++e) \
                gsc[s2][i][e] = GS[(mc_ + 16 * i + 4 * g + e) * HW + cb + 16 * (2 * cw + s2) + fr]; } } while (0)
        LDS_BARRIER();
#pragma unroll 1
        for (int c = 0; c < 8; ++c) {
            const size_t mc = m0 + c * 64; const int sb = (c & 1) * HSET;
            f32x4 o[2][4];
#pragma unroll
            for (int i = 0; i < 4; ++i) {
                u32x2v v2[2];
#pragma unroll
                for (int s2 = 0; s2 < 2; ++s2) v2[s2] = *(const LAS u32x2v*)(L + sb + HO_VT + (16 * (2 * cw + s2) + fr) * H_RT + (16 * i + 4 * g) * 2);
                bf16x8 ka[4], qb[4]; u32x2v qlo[4], qhi[4]; u32x2v k2[2]; f32x4 ge[2];
                if (FULL) {
#pragma unroll
                    for (int ks = 0; ks < 4; ++ks) { ka[ks] = *(const LAS bf16x8*)(L + sb + HO_KD + (16 * i + fr) * H_RS + 16 * g + 64 * ks); qb[ks] = *(const LAS bf16x8*)(L + sb + HO_QA + (16 * i + fr) * H_RS + 16 * g + 64 * ks); }
#pragma unroll
                    for (int u = 0; u < 4; ++u) { qlo[u] = *(const LAS u32x2v*)(L + sb + HO_QA + (16 * i + fr) * H_RS + (32 * u + 4 * g) * 2); qhi[u] = *(const LAS u32x2v*)(L + sb + HO_QA + (16 * i + fr) * H_RS + (32 * u + 16 + 4 * g) * 2); }
                }
                __builtin_amdgcn_sched_barrier(0);
                bf16x8 vb[2];
#pragma unroll
                for (int s2 = 0; s2 < 2; ++s2) vb[s2] = __builtin_bit_cast(bf16x8, (v4u){v2[s2].x, v2[s2].y, 0u, 0u});
                if (FULL) {
                    f32x4 cacc = {0.f, 0.f, 0.f, 0.f};
#pragma unroll
                    for (int ks = 0; ks < 4; ++ks) cacc = __builtin_amdgcn_mfma_f32_16x16x32_bf16(ka[ks], qb[ks], cacc, 0, 0, 0);
#pragma unroll
                    for (int e = 0; e < 4; ++e) if (4 * g + e > fr) cacc[e] = 0.f;
                    const bf16x8 pa = __builtin_bit_cast(bf16x8, (v4u){cvtpk(cacc[0], cacc[1]), cvtpk(cacc[2], cacc[3]), 0u, 0u});
                    __builtin_amdgcn_sched_barrier(0);
#pragma unroll
                    for (int kt = 0; kt < 2; ++kt) { k2[kt] = *(const LAS u32x2v*)(L + sb + HO_KBT + (16 * kt + fr) * H_RT + (16 * i + 4 * g) * 2); ge[kt] = *(const LAS f32x4*)(L + sb + HO_E + (i * 128 + 16 * kt + 4 * g) * 4); }
                    __builtin_amdgcn_sched_barrier(0);
#pragma unroll
                    for (int s2 = 0; s2 < 2; ++s2) {
                        f32x4 a = __builtin_amdgcn_mfma_f32_16x16x32_bf16(pa, vb[s2], (f32x4){0.f, 0.f, 0.f, 0.f}, 0, 0, 0);
#pragma unroll
                        for (int u = 0; u < 4; ++u) { const bf16x8 qa = __builtin_bit_cast(bf16x8, (v4u){qlo[u].x, qlo[u].y, qhi[u].x, qhi[u].y});
                            const bf16x8 sbv = __builtin_bit_cast(bf16x8, (v4u){cvtpk(S[s2][2 * u][0], S[s2][2 * u][1]), cvtpk(S[s2][2 * u][2], S[s2][2 * u][3]), cvtpk(S[s2][2 * u + 1][0], S[s2][2 * u + 1][1]), cvtpk(S[s2][2 * u + 1][2], S[s2][2 * u + 1][3])});
                            a = __builtin_amdgcn_mfma_f32_16x16x32_bf16(qa, sbv, a, 0, 0, 0); }
                        o[s2][i] = a; }
                } else {
#pragma unroll
                    for (int kt = 0; kt < 2; ++kt) { k2[kt] = *(const LAS u32x2v*)(L + sb + HO_KBT + (16 * kt + fr) * H_RT + (16 * i + 4 * g) * 2); ge[kt] = *(const LAS f32x4*)(L + sb + HO_E + (i * 128 + 16 * kt + 4 * g) * 4); }
                }
#pragma unroll
                for (int pr = 0; pr < 4; ++pr) {
                    u32x2v k2n[2]; f32x4 gen[2];
                    if (pr < 3) {
#pragma unroll
                        for (int kt = 0; kt < 2; ++kt) { k2n[kt] = *(const LAS u32x2v*)(L + sb + HO_KBT + (16 * (2 * pr + 2 + kt) + fr) * H_RT + (16 * i + 4 * g) * 2); gen[kt] = *(const LAS f32x4*)(L + sb + HO_E + (i * 128 + 16 * (2 * pr + 2 + kt) + 4 * g) * 4); } }
                    __builtin_amdgcn_sched_barrier(0);
#pragma unroll
                    for (int kt = 0; kt < 2; ++kt) { const bf16x8 kb8 = __builtin_bit_cast(bf16x8, (v4u){k2[kt].x, k2[kt].y, 0u, 0u});
#pragma unroll
                        for (int s2 = 0; s2 < 2; ++s2) S[s2][2 * pr + kt] = __builtin_amdgcn_mfma_f32_16x16x32_bf16(kb8, vb[s2], S[s2][2 * pr + kt] * ge[kt], 0, 0, 0); }
                    if (pr < 3) {
#pragma unroll
                        for (int kt = 0; kt < 2; ++kt) { k2[kt] = k2n[kt]; ge[kt] = gen[kt]; } }
                    __builtin_amdgcn_sched_barrier(0);
                }
            }
            if (FULL) {
                HG_LOADG(c);
                f32x4 sq[4];
#pragma unroll
                for (int i = 0; i < 4; ++i) { sq[i] = o[0][i] * o[0][i] + o[1][i] * o[1][i];
#pragma unroll
                    for (int e = 0; e < 4; ++e) { sq[i][e] += row_ror(sq[i][e], 8); }
#pragma unroll
                    for (int e = 0; e < 4; ++e) { sq[i][e] += row_ror(sq[i][e], 4); }
#pragma unroll
                    for (int e = 0; e < 4; ++e) { sq[i][e] += row_ror(sq[i][e], 2); }
#pragma unroll
                    for (int e = 0; e < 4; ++e) { sq[i][e] += row_ror(sq[i][e], 1); } }
                if (fr == 0) {
#pragma unroll
                    for (int i = 0; i < 4; ++i) *(LAS f32x4*)(L + HO_RED + (cw * 64 + 16 * i + 4 * g) * 4) = sq[i]; }
                LDS_BARRIER();
#pragma unroll
                for (int i = 0; i < 4; ++i) { f32x4 tot = *(const LAS f32x4*)(L + HO_RED + (16 * i + 4 * g) * 4);
#pragma unroll
                    for (int ww = 1; ww < 4; ++ww) tot += *(const LAS f32x4*)(L + HO_RED + (ww * 64 + 16 * i + 4 * g) * 4);
#pragma unroll
                    for (int e = 0; e < 4; ++e) { const int t = 16 * i + 4 * g + e;
                        const float rs = __builtin_amdgcn_rsqf(tot[e] * (1.f / HDK) + EPS);
#pragma unroll
                        for (int s2 = 0; s2 < 2; ++s2) { const bf16 ov = (bf16)cvtpk(o[s2][i][e] * rs * nw[s2] * bf2f(gsc[s2][i][e]), 0.f); if (!dry) GS[(mc + t) * HW + cb + 16 * (2 * cw + s2) + fr] = ov; } } }
            }
            LDS_BARRIER();
        }
#undef HG_LOADG
        if (!FULL) {
#pragma unroll
            for (int s2 = 0; s2 < 2; ++s2)
#pragma unroll
                for (int kt = 0; kt < 8; ++kt)
#pragma unroll
                    for (int e = 0; e < 4; ++e) HS[((size_t)(unit * 8 + 2 * cw + s2) * 32 + kt * 4 + e) * 64 + lane] = S[s2][kt][e];
            LDS_BARRIER();
            LDS_BARRIER();
        }
        __builtin_amdgcn_s_setprio(0);
    }
}
__device__ __forceinline__ void hgrn_scan_phase(const Ptrs& p, int vcu, int G, int tid) {
    const GAS float* HS = (const GAS float*)(p.ws + WS_HS); const GAS float* HD = (const GAS float*)(p.ws + WS_HD); GAS float* HSS = (GAS float*)(p.ws + WS_HSS);
#pragma unroll 1
    for (int it = vcu * 512 + tid; it < BATCH * HH * 16384; it += G * 512) {
        const int seq = it >> 14, idx = it & 16383, r = (idx >> 6) & 31, ln = idx & 63, dk = 16 * (r >> 2) + 4 * (ln >> 4) + (r & 3);
        float ds[15], dd[15];
#pragma unroll
        for (int j = 0; j < 15; ++j) { const int uj = seq * 16 + j; ds[j] = HS[(size_t)uj * 16384 + idx]; dd[j] = HD[uj * 128 + dk]; }
        float s = 0.f;
#pragma unroll
        for (int j = 0; j < 15; ++j) { s = s * dd[j] + ds[j]; HSS[(size_t)(seq * 16 + j + 1) * 16384 + idx] = s; }
    }
}
template <bool FULL>
__device__ __forceinline__ void hgrn_phase(const Ptrs& p, int l, LAS unsigned char* L, int vcu, int G, int tid, int wave, int lane, bool dry) {
    constexpr int NU = BATCH * HH * (T / 512);
#pragma unroll 1
    for (int unit = vcu; unit < NU; unit += G) hgrn_unit<FULL>(p, l, L, unit, tid, wave, lane, dry);
}


constexpr int NWAVES = 8;
constexpr int RING_OFF = 0, RING_BYTES = 155648;
constexpr int LDSCTL_OFF = RING_BYTES, MISC_OFF = LDSCTL_OFF + 320;
constexpr int LDS_BYTES = 163840;
static_assert(HO_END <= RING_BYTES, "HGRN LDS map");
constexpr int CW_BAR = 4096;
constexpr size_t CTL_ZERO_BYTES = 192 * 1024;
constexpr int NPHASE = 13;
static_assert((CW_BAR + XCD_BAR_WORDS) * 4 <= 131072 && 131072 + 128 * 256 <= (int)CTL_ZERO_BYTES, "barrier words and panel counters inside the memset region (one launch: barrier region 0 only)");

#ifndef MK_PROBES
#define MK_PROBES 0
#endif
static_assert(DEPTH == 2, "the out-projection epilogue distinguishes only a first and a last layer");
struct Args { Ptrs p; int ph_lo, ph_hi, li, probe; };

__device__ __forceinline__ float wave_sum(float v) {
#pragma unroll
    for (int o = 1; o < 64; o <<= 1) v += __shfl_xor(v, o);
    return v;
}
__device__ __forceinline__ void p0_transpose_item(const float* W, int K, int N, bf16* WT, LAS float* scr, int item, int lane, const float* kscale, bool permute) {
    const int nblk = N / 32, kb = item / nblk, nb = item % nblk, k0 = 64 * kb, n0 = 32 * nb;
    const int nsrc = permute ? src_col(n0 + (lane & 31)) : n0 + (lane & 31);
    float wv[32];
#pragma unroll
    for (int i = 0; i < 32; ++i) wv[i] = W[(size_t)(k0 + 2 * i + (lane >> 5)) * N + nsrc];
#pragma unroll
    for (int i = 0; i < 32; ++i) { const int kk = 2 * i + (lane >> 5); float v = wv[i]; if (kscale) v *= kscale[k0 + kk]; scr[kk * 33 + (lane & 31)] = v; }
    LDS_WAIT(); asm volatile("" ::: "memory");
    const int c = lane & 7;
#pragma unroll
    for (int j = 0; j < 4; ++j) { const int n = (lane >> 3) + 8 * j; const LAS float* s = scr + (8 * c) * 33 + n;
        v4u o; o.x = pk2(s[0 * 33], s[1 * 33]); o.y = pk2(s[2 * 33], s[3 * 33]); o.z = pk2(s[4 * 33], s[5 * 33]); o.w = pk2(s[6 * 33], s[7 * 33]);
        *(GAS v4u*)(WT + (size_t)(n0 + n) * K + k0 + 8 * c) = o; }
    LDS_WAIT(); asm volatile("" ::: "memory");
}
__device__ __forceinline__ double inv_freq_d(int f) {
    return f == 0 ? 1.0 : f == 1 ? 0.19392274474868576 : f == 2 ? 0.03760603093086393 : f == 3 ? 0.007292664737217109 : f == 4 ? 0.001414213562373095 : f == 5 ? 0.0002742481756762073 : f == 6 ? 5.318295896944988e-05 : 1.031338537721246e-05;
}
__device__ __forceinline__ void p0_prologue(const Ptrs& p, LAS unsigned char* L, int vcu, int G, int wave, int lane, int tid) {
    LAS float* scr = (LAS float*)(L + RING_OFF + wave * 16384);
    const int gw = vcu * NWAVES + wave, NGW = G * NWAVES;
    constexpr int I_IN = (D / 64) * (NIN / 32), I_U = (AW / 64) * (D / 32), I_O = (D / 64) * (D / 32), I_L = I_IN + 2 * I_U + I_O;
#pragma unroll 1
    for (int st = gw; st < I_L || st * 4 < M; st += NGW) {
        const int m4 = st * 4; const bool rows = m4 < M;
        f32x4 v[4][4];
        if (rows) {
#pragma unroll
            for (int rr = 0; rr < 4; ++rr)
#pragma unroll
                for (int j = 0; j < 4; ++j) v[rr][j] = ((const GAS f32x4*)(p.x + (size_t)(m4 + rr) * D) + lane)[64 * j]; }
        if (st < I_L) {
            const int l = 0; int r = st;
            if (r < I_IN) p0_transpose_item(p.w_in + (size_t)l * D * NIN, D, NIN, (bf16*)(p.ws + WS_WIN) + (size_t)l * NIN * D, scr, r, lane, p.norm_w + l * D, true);
            else if ((r -= I_IN) < I_U) p0_transpose_item(p.w_ua + (size_t)l * AW * D, AW, D, (bf16*)(p.ws + WS_WUA) + (size_t)l * D * AW, scr, r, lane, nullptr, false);
            else if ((r -= I_U) < I_U) p0_transpose_item(p.w_uh + (size_t)l * AW * D, AW, D, (bf16*)(p.ws + WS_WUH) + (size_t)l * D * AW, scr, r, lane, nullptr, false);
            else p0_transpose_item(p.w_out + (size_t)l * D * D, D, D, (bf16*)(p.ws + WS_WOUT) + (size_t)l * D * D, scr, r - I_U, lane, nullptr, false);
        }
        if (rows) {
#pragma unroll
            for (int rr = 0; rr < 4; ++rr) { const int m = m4 + rr;
#pragma unroll
                for (int j = 0; j < 4; ++j) { float s = (v[rr][j][0] * v[rr][j][0] + v[rr][j][1] * v[rr][j][1]) + (v[rr][j][2] * v[rr][j][2] + v[rr][j][3] * v[rr][j][3]);
                    s += __shfl_xor(s, 1); s += __shfl_xor(s, 2); s += __shfl_xor(s, 4); s += __shfl_xor(s, 8);
                    ((GAS unsigned long long*)((bf16*)(p.ws + WS_XB) + (size_t)m * D))[64 * j + lane] = (unsigned long long)pk2(v[rr][j][0], v[rr][j][1]) | ((unsigned long long)pk2(v[rr][j][2], v[rr][j][3]) << 32);
                    if ((lane & 15) == 0) ((float*)(p.ws + WS_SSQ))[(size_t)m * 16 + 4 * j + (lane >> 4)] = s; } }
        }
    }
    for (int i = vcu * (NWAVES * 64) + tid; i < M * 8; i += G * NWAVES * 64) {
        const int m = i >> 3, f = i & 7;
        const double ang = (double)p.pos[m] * inv_freq_d(f);
        const double rev = ang * 0.15915494309189535, fr = rev - __builtin_rint(rev);
        const float a = (float)(fr * 6.283185307179586);
        ((float*)(p.ws + WS_COS))[i] = cosf(a); ((float*)(p.ws + WS_SIN))[i] = sinf(a);
        if (i < HW) { float mx = -1e30f;
            for (int l = 0; l < DEPTH; ++l) mx = fmaxf(mx, p.lb_logits[l * HW + i]);
            float den = 0.f; for (int l = 0; l < DEPTH; ++l) den += pg8::fexp(p.lb_logits[l * HW + i] - mx);
            float acc = 0.f; for (int l = 0; l < DEPTH; ++l) { const float s = pg8::fexp(p.lb_logits[l * HW + i] - mx) / den; if (l > 0) acc += s; ((float*)(p.ws + WS_LB))[l * HW + i] = acc; } }
    }
}
__device__ __forceinline__ void late_weights(const Ptrs& p, LAS unsigned char* L, int wave, int lane, int wv, int nwv) {
    LAS float* scr = (LAS float*)(L + RING_OFF + wave * 16384);
    constexpr int I_IN = (D / 64) * (NIN / 32), I_U = (AW / 64) * (D / 32), I_O = (D / 64) * (D / 32), I_L = I_IN + 2 * I_U + I_O;
#pragma unroll 1
    for (int st = I_L + wv; st < DEPTH * I_L; st += nwv) {
        const int l = st / I_L; int r = st % I_L;
        if (r < I_IN) p0_transpose_item(p.w_in + (size_t)l * D * NIN, D, NIN, (bf16*)(p.ws + WS_WIN) + (size_t)l * NIN * D, scr, r, lane, p.norm_w + l * D, true);
        else if ((r -= I_IN) < I_U) p0_transpose_item(p.w_ua + (size_t)l * AW * D, AW, D, (bf16*)(p.ws + WS_WUA) + (size_t)l * D * AW, scr, r, lane, nullptr, false);
        else if ((r -= I_U) < I_U) p0_transpose_item(p.w_uh + (size_t)l * AW * D, AW, D, (bf16*)(p.ws + WS_WUH) + (size_t)l * D * AW, scr, r, lane, nullptr, false);
        else p0_transpose_item(p.w_out + (size_t)l * D * D, D, D, (bf16*)(p.ws + WS_WOUT) + (size_t)l * D * D, scr, r - I_U, lane, nullptr, false);
    }
}
__device__ __forceinline__ void final_norm_phase(const Ptrs& p, int vcu, int G, int wave, int lane) {
    const int gw = vcu * NWAVES + wave, NGW = G * NWAVES;
    f32x4 w[4];
#pragma unroll
    for (int j = 0; j < 4; ++j) w[j] = ((const f32x4*)p.fnw)[64 * j + lane];
    for (int m = gw; m < M; m += NGW) {
        const f32x4* sp = (const f32x4*)((const float*)(p.ws + WS_SSQ) + (size_t)m * 16);
        const f32x4 a = (sp[0] + sp[1]) + (sp[2] + sp[3]);
        const float r = __builtin_amdgcn_rsqf(((a[0] + a[1]) + (a[2] + a[3])) * (1.f / D) + EPS);
        f32x4* xr = (f32x4*)(p.out + (size_t)m * D) + lane;
#pragma unroll
        for (int j = 0; j < 4; ++j) xr[64 * j] = xr[64 * j] * r * w[j];
    }
}

__global__ void __launch_bounds__(NWAVES * 64, 2) fwd(Args args) {
    extern __shared__ __attribute__((aligned(16))) unsigned char lds[];
    LAS unsigned char* L = (LAS unsigned char*)lds;
    volatile LAS unsigned* MISC = (volatile LAS unsigned*)(L + MISC_OFF);
    const int tid = threadIdx.x, wave = __builtin_amdgcn_readfirstlane(tid >> 6);
    const int G = gridDim.x, bx = blockIdx.x, vcu = (G % 8 == 0) ? (bx % 8) * (G / 8) + bx / 8 : bx;
    const Ptrs& p = args.p; unsigned char* ws = p.ws;
    for (int u = tid; u < (LDS_BYTES - LDSCTL_OFF) / 4; u += NWAVES * 64) ((LAS unsigned*)(L + LDSCTL_OFF))[u] = 0u;
    __syncthreads();
    const int lo = args.ph_lo, hi = args.ph_hi;
    XcdBarrier bar; bar.bar = (unsigned*)(ws + WS_CTL) + CW_BAR + args.li * XCD_BAR_WORDS; bar.x = 0; bar.st = nullptr;
    if (hi - lo > 1) bar = xcd_barrier_post((unsigned*)(ws + WS_CTL) + CW_BAR + args.li * XCD_BAR_WORDS, MISC + 8);
#define IN(k) (lo <= (k) && (k) < hi)
#if MK_PROBES
#define REP(k) _Pragma("unroll 1") for (int rep_ = 0; rep_ < ((k) == args.probe ? 2 : 1); ++rep_)
#define DRY (rep_ != 0)
#define STAMP(i) do { if (args.probe >= 200 && bx == 0 && threadIdx.x == 0) TS[i] = rt(); } while (0)
#else
#define REP(k)
#define DRY false
#define STAMP(i) do { } while (0)
#endif
#define PH_TID int tid_ = threadIdx.x; asm volatile("" : "+v"(tid_)); const int lane_ = tid_ & 63; (void)lane_
#define SEAM(k) do { if (IN(k) && IN((k) + 1)) xcd_barrier(bar); STAMP((k) + 1); } while (0)
#if MK_PROBES
    unsigned long long* TS = (unsigned long long*)(ws + WS_CTL + 65536);
#endif
    STAMP(0);

    if (IN(0)) REP(0) { PH_TID; p0_prologue(p, L, vcu, G, wave, lane_, tid_); }
    SEAM(0);
#pragma unroll 1
    for (int l = 0; l < DEPTH; ++l) {
        const int pb = 1 + 6 * l;
        if (IN(pb)) REP(pb) {
            GAS unsigned char* ws = (GAS unsigned char*)p.ws; asm volatile("" : "+s"(ws));
            pg8::Gemm g{(const bf16*)(ws + WS_XB), (const bf16*)(ws + WS_WIN) + (size_t)l * NIN * D, M, NIN, D, nullptr, nullptr}; pg8::StaticOrder S; S.init(M, NIN, G, bx);
            pg8::EpiInProj E{ws, l, DRY};
            pg8::gemm_phase<pg8::EpiInProj, pg8::StaticOrder, true, true>(L + RING_OFF, g, S, E);
            if (l == 0 && !DRY) {
                constexpr int NUNIT = (M / 256) * (NIN / 256); const int nlong = NUNIT % G;
                if (nlong != 0 ? bx >= nlong : true) { PH_TID; __syncthreads(); late_weights(p, L, wave, lane_, (nlong != 0 ? bx - nlong : bx) * NWAVES + wave, (nlong != 0 ? G - nlong : G) * NWAVES); }
            }
        }
        SEAM(pb);
        if (IN(pb + 1)) REP(pb + 1) {
            Ptrs q = p; asm volatile("" : "+s"(q.ws));
            PH_TID;
            attn_phase(q, l, L + RING_OFF, vcu, G, tid_, wave, lane_, DRY);
            if (l == 0) STAMP(15);
            hgrn_phase<false>(q, l, L + RING_OFF, vcu, G, tid_, wave, lane_, DRY);
        }
        SEAM(pb + 1);
        if (IN(pb + 2)) REP(pb + 2) {
            Ptrs q = p; asm volatile("" : "+s"(q.ws));
            PH_TID; hgrn_scan_phase(q, vcu, G, tid_);
        }
        SEAM(pb + 2);
        if (IN(pb + 3)) REP(pb + 3) {
            Ptrs q = p; asm volatile("" : "+s"(q.ws));
            PH_TID;
            hgrn_phase<true>(q, l, L + RING_OFF, vcu, G, tid_, wave, lane_, DRY);
        }
        SEAM(pb + 3);
        if (IN(pb + 4)) REP(pb + 4) {
            GAS unsigned char* ws = (GAS unsigned char*)p.ws; asm volatile("" : "+s"(ws));
            pg8::Gemm g{(const bf16*)(ws + WS_ZS), (const bf16*)(ws + WS_WUA) + (size_t)l * D * AW, M, D, AW, (const bf16*)(ws + WS_GS), (const bf16*)(ws + WS_WUH) + (size_t)l * D * AW}; pg8::StaticOrder2 S; S.init(M, D, G, bx);
            pg8::EpiUp2 E{ws, DRY};
            pg8::gemm_phase<pg8::EpiUp2, pg8::StaticOrder2, true, true>(L + RING_OFF, g, S, E);
        }
        SEAM(pb + 4);
        if (IN(pb + 5)) REP(pb + 5) {
            GAS unsigned char* ws = (GAS unsigned char*)p.ws; asm volatile("" : "+s"(ws));
            pg8::Gemm g{(const bf16*)(ws + WS_GA), (const bf16*)(ws + WS_WOUT) + (size_t)l * D * D, M, D, D, nullptr, nullptr}; pg8::StaticOrder S; S.init(M, D, G, bx);
            pg8::EpiOut E{ws, (const GAS float*)p.x, (GAS float*)p.out, (const GAS float*)p.fnw, L + 131072, l == DEPTH - 1, DRY};
            pg8::gemm_phase<pg8::EpiOut, pg8::StaticOrder, true, true>(L + RING_OFF, g, S, E);
        }
        SEAM(pb + 5);
    }
#if MK_PROBES
    if (args.probe >= 200 && bx == 0 && threadIdx.x == 0) {
        TS[13] = rt(); const int c = args.probe - 200, ilo = c >> 4, ihi = c & 15;
        const unsigned long long target = 250000ull + (TS[ihi] - TS[ilo]);
        while (rt() - TS[0] < target) __builtin_amdgcn_s_sleep(32);
    }
#endif
#undef REP
#undef DRY
#undef STAMP
#undef PH_TID
#undef IN
#undef SEAM
}

constexpr int PROBE_PHASE = -1;
static void launch_fwd(const Ptrs& p, int lo, int hi, int li, int grid, hipStream_t stream) {
    Args a{}; a.p = p; a.ph_lo = lo; a.ph_hi = hi; a.li = li; a.probe = PROBE_PHASE;
    hipLaunchKernelGGL(fwd, dim3(grid), dim3(NWAVES * 64), LDS_BYTES, stream, a);
}
extern "C" void kernel_launch(void* const* d_in, const int* in_sizes, int n_in, void* d_out, int out_size, void* d_ws, size_t ws_size, hipStream_t stream) {
    static int grid = 0;
    if (grid == 0) {
        if (n_in != 11 || in_sizes[0] != M * D || out_size != M * D || ws_size < WS_END) { fprintf(stderr, "kernel_launch: unexpected shapes / workspace (%d inputs, in0 %d, out %d, ws %zu)\n", n_in, n_in > 0 ? in_sizes[0] : -1, out_size, ws_size); grid = -1; return; }
        int dev = 0, cus = 0, per_cu = 0;
        if (hipGetDevice(&dev) != hipSuccess || hipDeviceGetAttribute(&cus, hipDeviceAttributeMultiprocessorCount, dev) != hipSuccess) { grid = -1; return; }
        if (hipFuncSetAttribute((const void*)fwd, hipFuncAttributeMaxDynamicSharedMemorySize, LDS_BYTES) != hipSuccess) { fprintf(stderr, "kernel_launch: hipFuncSetAttribute failed\n"); grid = -1; return; }
        if (hipOccupancyMaxActiveBlocksPerMultiprocessor(&per_cu, (const void*)fwd, NWAVES * 64, LDS_BYTES) != hipSuccess || per_cu < 1) fprintf(stderr, "kernel_launch: occupancy query reports %d blocks per CU\n", per_cu);
        (void)hipGetLastError();
        grid = cus;
    }
    if (grid < 0) return;
    Ptrs p{};
    p.x = (const float*)d_in[0]; p.pos = (const int*)d_in[1]; p.norm_w = (const float*)d_in[2]; p.w_in = (const float*)d_in[3]; p.sinks = (const float*)d_in[4]; p.hnw = (const float*)d_in[5];
    p.w_ua = (const float*)d_in[6]; p.w_uh = (const float*)d_in[7]; p.w_out = (const float*)d_in[8]; p.lb_logits = (const float*)d_in[9]; p.fnw = (const float*)d_in[10];
    p.out = (float*)d_out; p.ws = (unsigned char*)d_ws;
    (void)hipMemsetAsync((char*)d_ws + WS_CTL, 0, CTL_ZERO_BYTES, stream);
    launch_fwd(p, 0, NPHASE, 0, grid, stream);
}
```
